# Optimizing an MI355X kernel written in HIP

```python
import math
import jax
import jax.numpy as jnp
from jax import lax
import numpy as np

D_MODEL = 2048
BATCH = 4
SEQ = 2048
DEPTH = 2

GRID_W = 64
CTX_LEN = 256
ROPE_BASE = 10000.0
NORM_EPS = 1e-6
Q_BLOCK = 128
CHUNK = 64

DIFF_HEADS = 8
DIFF_QK = 32
DIFF_V = 64
NA_HEADS = 8
NA_DIM = 64
NA_WIN_R = 8
NA_WIN_C = 16
HG_HEADS = 4
HG_DIM = 128
GLA_HEADS = 4
GLA_DK = 64
GLA_DV = 128
GLA_GATE_RANK = 16
GLA_GATE_TAU = 16.0

MIX_WIDTH = DIFF_HEADS * DIFF_V + NA_HEADS * NA_DIM + HG_HEADS * HG_DIM + GLA_HEADS * GLA_DV

IN_SPLITS = (
    DIFF_HEADS * 2 * DIFF_QK, DIFF_HEADS * 2 * DIFF_QK, DIFF_HEADS * DIFF_V,
    NA_HEADS * NA_DIM, NA_HEADS * NA_DIM, NA_HEADS * NA_DIM,
    HG_HEADS * HG_DIM, HG_HEADS * HG_DIM, HG_HEADS * HG_DIM, HG_HEADS * HG_DIM, HG_HEADS * HG_DIM,
    GLA_HEADS * GLA_DK, GLA_HEADS * GLA_DK, GLA_HEADS * GLA_DV, 2 * GLA_GATE_RANK, GLA_HEADS * GLA_DV,
)
IN_WIDTH = sum(IN_SPLITS)

FFN_DENSE = 5632
N_EXPERTS = 8
TOP_K = 2
FFN_EXPERT = 7168
N_DENSE_LAYERS = (DEPTH + 1) // 2
N_MOE_LAYERS = DEPTH // 2

kernel_name = 'hybrid_diffusion_parallel_heads'


def rmsnorm(x, g):
    xf = x.astype(jnp.float32)
    y = xf * lax.rsqrt(jnp.mean(xf * xf, axis=-1, keepdims=True) + NORM_EPS)
    return (y * g.astype(jnp.float32)).astype(x.dtype)


def split_cols(p):
    return jnp.split(p, np.cumsum(IN_SPLITS)[:-1].tolist(), axis=-1)


def axial_rope(n_tok, dim):
    pairs = dim // 2
    per_axis = pairs // 2
    t = jnp.arange(n_tok)
    row = (t // GRID_W).astype(jnp.float32)
    col = (t % GRID_W).astype(jnp.float32)
    inv = ROPE_BASE ** (-jnp.arange(per_axis, dtype=jnp.float32) / per_axis)
    ang = jnp.concatenate([row[:, None] * inv, col[:, None] * inv], axis=-1)
    return jnp.cos(ang), jnp.sin(ang)


def apply_rope(x, cos, sin):
    shape = (1, x.shape[1]) + (1,) * (x.ndim - 3) + (cos.shape[-1],)
    cs = cos.reshape(shape).astype(x.dtype)
    sn = sin.reshape(shape).astype(x.dtype)
    x1, x2 = jnp.split(x, 2, axis=-1)
    return jnp.concatenate([x1 * cs - x2 * sn, x1 * sn + x2 * cs], axis=-1)


def dense_attention(q, k, v, scale):
    s = jnp.einsum('bqhd,bkhd->bhqk', q, k).astype(jnp.float32) * scale
    p = jax.nn.softmax(s, axis=-1).astype(v.dtype)
    return jnp.einsum('bhqk,bkhd->bqhd', p, v)


def diff_core(q, k, v, lam):
    s = jnp.einsum('bqhmd,bkhmd->bhmqk', q, k).astype(jnp.float32) * (DIFF_QK ** -0.5)
    p = jax.nn.softmax(s, axis=-1)
    w = (p[:, :, 0] - lam * p[:, :, 1]).astype(v.dtype)
    return jnp.einsum('bhqk,bkhd->bqhd', w, v)


def diff_attention_mixer(q_l, k_l, v_l, q_c, k_c, v_c, lam_params, norm_g, lambda_init, ctx_out):
    B, S, _ = q_l.shape
    n_ctx = k_c.shape[1]
    qk_shape = lambda n: (B, n, DIFF_HEADS, 2, DIFF_QK)
    cos, sin = axial_rope(S, DIFF_QK)
    q_l = apply_rope(q_l.reshape(qk_shape(S)), cos, sin)
    k_l = apply_rope(k_l.reshape(qk_shape(S)), cos, sin)
    v_l = v_l.reshape(B, S, DIFF_HEADS, DIFF_V)
    k_c = k_c.reshape(qk_shape(n_ctx))
    v_c = v_c.reshape(B, n_ctx, DIFF_HEADS, DIFF_V)
    lp = lam_params.astype(jnp.float32)
    lam = jnp.exp(jnp.sum(lp[0] * lp[1])) - jnp.exp(jnp.sum(lp[2] * lp[3])) + lambda_init
    k_all = jnp.concatenate([k_c, k_l], axis=1)
    v_all = jnp.concatenate([v_c, v_l], axis=1)
    n_blk = S // Q_BLOCK
    q_blocks = q_l.reshape(B, n_blk, Q_BLOCK, DIFF_HEADS, 2, DIFF_QK).transpose(1, 0, 2, 3, 4, 5)
    o_l = lax.map(lambda qb: diff_core(qb, k_all, v_all, lam), q_blocks)
    o_l = o_l.transpose(1, 0, 2, 3, 4).reshape(B, S, DIFF_HEADS, DIFF_V)

    def post(o):
        return (rmsnorm(o, norm_g) * (1.0 - lambda_init)).reshape(o.shape[0], o.shape[1], -1)

    o_c = post(diff_core(q_c.reshape(qk_shape(n_ctx)), k_c, v_c, lam)) if ctx_out else None
    return o_c, post(o_l)


def neighbourhood_attention_mixer(q_l, k_l, v_l, q_c, k_c, v_c, rel_bias, ctx_out):
    B, S, _ = q_l.shape
    n_ctx = k_c.shape[1]
    rows = S // GRID_W
    win_r = min(NA_WIN_R, rows)
    scale = NA_DIM ** -0.5
    r = jnp.arange(rows)
    row_start = jnp.clip(r - win_r // 2, 0, rows - win_r)
    row_idx = row_start[:, None] + jnp.arange(win_r)[None, :]
    cc = jnp.arange(GRID_W)
    col_start = jnp.clip(cc - NA_WIN_C // 2, 0, GRID_W - NA_WIN_C)
    col_ok = (cc[None, :] >= col_start[:, None]) & (cc[None, :] < col_start[:, None] + NA_WIN_C)
    dr = row_idx - r[:, None] + (NA_WIN_R - 1)
    dc = jnp.clip(cc[None, :] - cc[:, None], -(NA_WIN_C - 1), NA_WIN_C - 1) + (NA_WIN_C - 1)
    bias = rel_bias.astype(jnp.float32)[:, dr[:, None, :, None], dc[None, :, None, :]]

    q_g = q_l.reshape(B, rows, GRID_W, NA_HEADS, NA_DIM)
    k_g = k_l.reshape(B, rows, GRID_W, NA_HEADS, NA_DIM)[:, row_idx]
    v_g = v_l.reshape(B, rows, GRID_W, NA_HEADS, NA_DIM)[:, row_idx]
    k_c = k_c.reshape(B, n_ctx, NA_HEADS, NA_DIM)
    v_c = v_c.reshape(B, n_ctx, NA_HEADS, NA_DIM)

    s_lat = jnp.einsum('brchd,brkwhd->bhrckw', q_g, k_g).astype(jnp.float32) * scale + bias[None]
    s_lat = jnp.where(col_ok[:, None, :], s_lat, -jnp.inf)
    s_ctx = jnp.einsum('brchd,bjhd->bhrcj', q_g, k_c).astype(jnp.float32) * scale
    n_lat = win_r * GRID_W
    s = jnp.concatenate([s_lat.reshape(B, NA_HEADS, rows, GRID_W, n_lat), s_ctx], axis=-1)
    p = jax.nn.softmax(s, axis=-1).astype(v_l.dtype)
    p_lat = p[..., :n_lat].reshape(B, NA_HEADS, rows, GRID_W, win_r, GRID_W)
    p_ctx = p[..., n_lat:]
    o_l = (jnp.einsum('bhrckw,brkwhd->brchd', p_lat, v_g)
           + jnp.einsum('bhrcj,bjhd->brchd', p_ctx, v_c)).reshape(B, S, NA_HEADS * NA_DIM)
    o_c = None
    if ctx_out:
        o_c = dense_attention(q_c.reshape(B, n_ctx, NA_HEADS, NA_DIM), k_c, v_c, scale).reshape(B, n_ctx, -1)
    return o_c, o_l


def chunk_gla(q, k, v, log_g, state0):
    B, T, H, _ = q.shape
    Dv = v.shape[-1]
    n = T // CHUNK

    def blocks(a):
        return a.astype(jnp.float32).reshape(B, n, CHUNK, H, a.shape[-1]).transpose(1, 0, 3, 2, 4)

    causal = jnp.tril(jnp.ones((CHUNK, CHUNK), dtype=bool))[:, :, None]

    def step(S, xs):
        qi, ki, vi, gi = xs
        b = jnp.cumsum(gi, axis=2)
        rel = jnp.exp(jnp.where(causal, b[:, :, :, None, :] - b[:, :, None, :, :], -jnp.inf))
        att = jnp.einsum('bhtd,bhsd,bhtsd->bhts', qi, ki, rel)
        o = att @ vi + jnp.einsum('bhtd,bhdv->bhtv', qi * jnp.exp(b), S)
        b_end = b[:, :, -1:, :]
        S = jnp.exp(b_end[:, :, 0, :])[..., None] * S + jnp.einsum('bhsd,bhsv->bhdv', ki * jnp.exp(b_end - b), vi)
        return S, o

    S_end, o = lax.scan(step, state0, (blocks(q), blocks(k), blocks(v), blocks(log_g)))
    return o.transpose(1, 0, 3, 2, 4).reshape(B, T, H, Dv).astype(v.dtype), S_end


def gla_final_state(k, v, log_g):
    b = jnp.cumsum(log_g.astype(jnp.float32), axis=1)
    w = k.astype(jnp.float32) * jnp.exp(b[:, -1:] - b)
    return jnp.einsum('bthd,bthv->bhdv', w, v.astype(jnp.float32))


def bidirectional_gla(inp_c, inp_l, scale, ctx_out):
    q_c, v_c, dirs_c = inp_c
    q_l, v_l, dirs_l = inp_l
    B, _, H, Dk = q_l.shape
    Dv = v_l.shape[-1]
    zero = jnp.zeros((B, H, Dk, Dv), jnp.float32)
    q_c = q_c * scale
    q_l = q_l * scale
    o_c = None
    o_l = None
    for d, rev in ((0, False), (1, True)):
        fl = (lambda a: jnp.flip(a, axis=1)) if rev else (lambda a: a)
        k_c, g_c = dirs_c[d]
        k_l, g_l = dirs_l[d]
        if ctx_out:
            oc, s_ctx = chunk_gla(fl(q_c), fl(k_c), fl(v_c), fl(g_c), zero)
            o_c = fl(oc) if o_c is None else o_c + fl(oc)
        else:
            s_ctx = gla_final_state(fl(k_c), fl(v_c), fl(g_c))
        ol, _ = chunk_gla(fl(q_l), fl(k_l), fl(v_l), fl(g_l), s_ctx)
        o_l = fl(ol) if o_l is None else o_l + fl(ol)
    return o_c, o_l


def hgrn2_mixer(parts_c, parts_l, lb_f, lb_b, norm_g, ctx_out):
    def prep(parts):
        q, i, f_f, f_b, g = parts
        B, T, _ = q.shape
        heads = lambda a: a.reshape(B, T, HG_HEADS, HG_DIM)
        dirs = []
        for f, lb in ((f_f, lb_f), (f_b, lb_b)):
            f = f.astype(jnp.float32)
            log_f = jnp.logaddexp(jnp.log(lb), jnp.log1p(-lb) + jax.nn.log_sigmoid(f))
            k = (1.0 - lb) * jax.nn.sigmoid(-f)
            dirs.append((heads(k), heads(log_f)))
        return (heads(jax.nn.silu(q)), heads(i), dirs), g

    in_c, g_c = prep(parts_c)
    in_l, g_l = prep(parts_l)
    o_c, o_l = bidirectional_gla(in_c, in_l, 1.0, ctx_out)

    def post(o, g):
        return rmsnorm(o, norm_g).reshape(o.shape[0], o.shape[1], -1) * jax.nn.silu(g)

    return (post(o_c, g_c) if ctx_out else None), post(o_l, g_l)


def gla_mixer(parts_c, parts_l, w2, b2, norm_g, ctx_out):
    def prep(parts):
        q, k, v, z, r = parts
        B, T, _ = q.shape
        k = k.reshape(B, T, GLA_HEADS, GLA_DK)
        dirs = []
        for d, zd in enumerate(jnp.split(z, 2, axis=-1)):
            log_g = jax.nn.log_sigmoid((zd @ w2[d] + b2[d]).astype(jnp.float32)) / GLA_GATE_TAU
            dirs.append((k, log_g.reshape(B, T, GLA_HEADS, GLA_DK)))
        return (q.reshape(B, T, GLA_HEADS, GLA_DK), v.reshape(B, T, GLA_HEADS, GLA_DV), dirs), r

    in_c, r_c = prep(parts_c)
    in_l, r_l = prep(parts_l)
    o_c, o_l = bidirectional_gla(in_c, in_l, GLA_DK ** -0.5, ctx_out)

    def post(o, r):
        return rmsnorm(o, norm_g).reshape(o.shape[0], o.shape[1], -1) * jax.nn.silu(r)

    return (post(o_c, r_c) if ctx_out else None), post(o_l, r_l)


def swiglu(h, w1, w3, w2):
    return (jax.nn.silu(h @ w1) * (h @ w3)) @ w2


def moe_swiglu(h, router_w, w1, w3, w2):
    logits = (h @ router_w).astype(jnp.float32)
    top_val, top_idx = lax.top_k(logits, TOP_K)
    top_w = jax.nn.softmax(top_val, axis=-1)
    gate = jnp.sum(jax.nn.one_hot(top_idx, N_EXPERTS, dtype=jnp.float32) * top_w[..., None], axis=-2)
    gate = gate.astype(h.dtype)
    out = jnp.zeros_like(h)
    for e in range(N_EXPERTS):
        out = out + gate[..., e:e + 1] * swiglu(h, w1[e], w3[e], w2[e])
    return out


def channel_mixer(h, l, ffn_w1, ffn_w3, ffn_w2, moe_router, moe_w1, moe_w3, moe_w2):
    if l % 2 == 0:
        return swiglu(h, ffn_w1[l // 2], ffn_w3[l // 2], ffn_w2[l // 2])
    return moe_swiglu(h, moe_router[l // 2], moe_w1[l // 2], moe_w3[l // 2], moe_w2[l // 2])


def setup_inputs(seed: int = 0) -> dict:
    key = jax.random.key(seed)
    ks = jax.random.split(key, 26)
    D = D_MODEL
    nrm = lambda k, shape, s: jax.random.normal(k, shape, jnp.float32) * s
    return {
        'x': nrm(ks[0], (BATCH, SEQ, D), 1.0),
        'c': nrm(ks[1], (BATCH, D), 1.0),
        'ctx': nrm(ks[2], (BATCH, CTX_LEN, D), 1.0),
        'c_ctx': nrm(ks[3], (D,), 1.0),
        'ada_w': nrm(ks[4], (DEPTH, D, 6 * D), 0.5 * D ** -0.5),
        'ada_b': nrm(ks[5], (DEPTH, 6 * D), 0.02),
        'norm_mix': 1.0 + nrm(ks[6], (DEPTH, D), 0.02),
        'norm_ffn': 1.0 + nrm(ks[7], (DEPTH, D), 0.02),
        'w_in': nrm(ks[8], (DEPTH, D, IN_WIDTH), D ** -0.5),
        'w_out': nrm(ks[9], (DEPTH, MIX_WIDTH, D), MIX_WIDTH ** -0.5),
        'diff_lambda': nrm(ks[10], (DEPTH, 4, DIFF_QK), 0.1),
        'diff_norm': 1.0 + nrm(ks[11], (DEPTH, DIFF_V), 0.02),
        'na_rel_bias': nrm(ks[12], (DEPTH, NA_HEADS, 2 * NA_WIN_R - 1, 2 * NA_WIN_C - 1), 0.1),
        'hgrn_lower_bounds': nrm(ks[13], (2, DEPTH, HG_HEADS * HG_DIM), 0.1),
        'hgrn_norm': 1.0 + nrm(ks[14], (DEPTH, HG_DIM), 0.02),
        'gla_gate_w2': nrm(ks[15], (DEPTH, 2, GLA_GATE_RANK, GLA_HEADS * GLA_DK), GLA_GATE_RANK ** -0.5),
        'gla_gate_b': nrm(ks[16], (DEPTH, 2, GLA_HEADS * GLA_DK), 0.1),
        'gla_norm': 1.0 + nrm(ks[17], (DEPTH, GLA_DV), 0.02),
        'ffn_w1': nrm(ks[18], (N_DENSE_LAYERS, D, FFN_DENSE), D ** -0.5),
        'ffn_w3': nrm(ks[19], (N_DENSE_LAYERS, D, FFN_DENSE), D ** -0.5),
        'ffn_w2': nrm(ks[20], (N_DENSE_LAYERS, FFN_DENSE, D), FFN_DENSE ** -0.5),
        'moe_router': nrm(ks[21], (N_MOE_LAYERS, D, N_EXPERTS), D ** -0.5),
        'moe_w1': nrm(ks[22], (N_MOE_LAYERS, N_EXPERTS, D, FFN_EXPERT), D ** -0.5),
        'moe_w3': nrm(ks[23], (N_MOE_LAYERS, N_EXPERTS, D, FFN_EXPERT), D ** -0.5),
        'moe_w2': nrm(ks[24], (N_MOE_LAYERS, N_EXPERTS, FFN_EXPERT, D), FFN_EXPERT ** -0.5),
        'final_norm': 1.0 + nrm(ks[25], (D,), 0.02),
    }


def reference(x, c, ctx, c_ctx, ada_w, ada_b, norm_mix, norm_ffn, w_in, w_out, diff_lambda, diff_norm,
              na_rel_bias, hgrn_lower_bounds, hgrn_norm, gla_gate_w2, gla_gate_b, gla_norm,
              ffn_w1, ffn_w3, ffn_w2, moe_router, moe_w1, moe_w3, moe_w2, final_norm):
    lb_soft = jax.nn.softmax(hgrn_lower_bounds.astype(jnp.float32), axis=1)
    lower_bounds = jnp.clip(jnp.cumsum(lb_soft, axis=1) - lb_soft[:, :1], 0.0, 1.0 - 1e-6)
    cond_l = jax.nn.silu(c)[:, None, :]
    cond_c = jax.nn.silu(c_ctx)[None, None, :]
    xc = ctx
    for l in range(DEPTH):
        ctx_out = l < DEPTH - 1
        mod_l = jnp.split(cond_l @ ada_w[l] + ada_b[l], 6, axis=-1)
        mod_c = jnp.split(cond_c @ ada_w[l] + ada_b[l], 6, axis=-1)
        h_l = rmsnorm(x, norm_mix[l]) * (1.0 + mod_l[1]) + mod_l[0]
        h_c = rmsnorm(xc, norm_mix[l]) * (1.0 + mod_c[1]) + mod_c[0]
        pl = split_cols(h_l @ w_in[l])
        pc = split_cols(h_c @ w_in[l])
        lambda_init = 0.8 - 0.6 * math.exp(-0.3 * l)
        a_c, a_l = diff_attention_mixer(pl[0], pl[1], pl[2], pc[0], pc[1], pc[2],
                                        diff_lambda[l], diff_norm[l], lambda_init, ctx_out)
        n_c, n_l = neighbourhood_attention_mixer(pl[3], pl[4], pl[5], pc[3], pc[4], pc[5],
                                                 na_rel_bias[l], ctx_out)
        r_c, r_l = hgrn2_mixer(pc[6:11], pl[6:11], lower_bounds[0, l], lower_bounds[1, l],
                               hgrn_norm[l], ctx_out)
        g_c, g_l = gla_mixer(pc[11:16], pl[11:16], gla_gate_w2[l], gla_gate_b[l], gla_norm[l], ctx_out)
        x = x + mod_l[2] * (jnp.concatenate([a_l, n_l, r_l, g_l], axis=-1) @ w_out[l])
        h_l = rmsnorm(x, norm_ffn[l]) * (1.0 + mod_l[4]) + mod_l[3]
        x = x + mod_l[5] * channel_mixer(h_l, l, ffn_w1, ffn_w3, ffn_w2, moe_router, moe_w1, moe_w3, moe_w2)
        if ctx_out:
            xc = xc + mod_c[2] * (jnp.concatenate([a_c, n_c, r_c, g_c], axis=-1) @ w_out[l])
            h_c = rmsnorm(xc, norm_ffn[l]) * (1.0 + mod_c[4]) + mod_c[3]
            xc = xc + mod_c[5] * channel_mixer(h_c, l, ffn_w1, ffn_w3, ffn_w2, moe_router, moe_w1, moe_w3, moe_w2)
    return rmsnorm(x, final_norm)
```

```cpp
#include <hip/hip_runtime.h>
#include <cstdio>
#include <cstdint>

#ifndef PROBE_DUP
#define PROBE_DUP -1
#endif
#ifndef MK_ONE_LAUNCH
#define MK_ONE_LAUNCH 1
#endif

#define GAS __attribute__((address_space(1)))
#define LAS __attribute__((address_space(3)))
typedef unsigned short bf16;
typedef short bf16x8 __attribute__((ext_vector_type(8)));
typedef float f32x4 __attribute__((ext_vector_type(4)));
typedef float f32x2 __attribute__((ext_vector_type(2)));
typedef unsigned u32x4 __attribute__((ext_vector_type(4)));
typedef unsigned u32x2 __attribute__((ext_vector_type(2)));

constexpr int D = 2048, NB = 4, SEQ = 2048, CTXL = 256, NLAT = NB * SEQ, NCTX = NB * CTXL, MT = NLAT + NCTX;
constexpr int KEYS = CTXL + SEQ;
constexpr int INW = 7200;
constexpr int NPI = 7168;
constexpr int FFD = 5632, FFE = 7168, NEXP = 8;
constexpr int MODW = 6 * D;
constexpr int A_Q = 0, A_K = 512, A_V = 1024, B_Q = 1536, B_K = 2048, B_V = 2560, C_Q = 3072, C_I = 3584, C_FF = 4096, C_FB = 4608, C_G = 5120,
              D_Q = 5632, D_K = 5888, D_V = 6144, D_R = 6656;
constexpr int Z_SRC = 6656;
constexpr float LOG2E = 1.4426950408889634f;
constexpr float NORM_EPS = 1e-6f;

constexpr size_t MiB = 1u << 20;
constexpr size_t al(size_t x) { return (x + 255) & ~(size_t)255; }
constexpr size_t WS_CTL = 0, CTL_BYTES = 1 * MiB;
constexpr size_t WS_MOD = WS_CTL + CTL_BYTES;
constexpr size_t WS_ROUTE = WS_MOD + al((size_t)2 * 5 * MODW * 4);
constexpr size_t WS_POS = WS_ROUTE + al((size_t)NLAT * 16);
constexpr size_t WS_Z = WS_POS + al((size_t)NLAT * 8);
constexpr size_t WS_WZT = WS_Z + al((size_t)MT * 32 * 4);
constexpr size_t WS_WIN = WS_WZT + al((size_t)2 * 32 * D * 2);
constexpr size_t WS_WOUT = WS_WIN + al((size_t)2 * NPI * D * 2);
constexpr size_t WS_W13 = WS_WOUT + al((size_t)2 * D * D * 2);
constexpr size_t WS_W2 = WS_W13 + al((size_t)2 * FFD * D * 2);
constexpr size_t WS_W13E = WS_W2 + al((size_t)D * FFD * 2);
constexpr size_t WS_W2E = WS_W13E + al((size_t)NEXP * 2 * FFE * D * 2);
constexpr size_t WS_X = WS_W2E + al((size_t)NEXP * D * FFE * 2);
constexpr size_t WS_H = WS_X + al((size_t)MT * D * 4);
constexpr size_t WS_P = WS_H + al((size_t)MT * D * 2);
constexpr size_t WS_MIX = WS_P + al((size_t)MT * NPI * 2);
constexpr size_t WS_VTA = WS_MIX + al((size_t)MT * D * 2);
constexpr size_t WS_VTB = WS_VTA + al((size_t)NB * 8 * 64 * KEYS * 2);
constexpr size_t WS_OC = WS_VTB + al((size_t)NB * 8 * 64 * KEYS * 2);
constexpr size_t WS_OD = WS_OC + al((size_t)2 * MT * 512 * 4);
constexpr int MPAD = 18432;
constexpr size_t WS_G = WS_OD + al((size_t)2 * MT * 512 * 4);
constexpr size_t WS_LG = WS_G + al((size_t)MPAD * FFE * 2);
constexpr size_t WS_HLA = WS_LG + al((size_t)2 * MT * 256 * 4);
constexpr int FFD_KS = 11, MOE_KS = 7, MOE_FULL_PANELS = 64, OUT_KS = 4;
constexpr size_t WS_SPLIT = WS_HLA + al((size_t)2 * MT * 512 * 4);
constexpr size_t WS_KNA = WS_SPLIT + al((size_t)MOE_KS * 8 * 256 * D * 4);
constexpr size_t WS_KNB = WS_KNA + al((size_t)NB * 16 * KEYS * 4);
constexpr size_t WS_BCNT = WS_KNB + al((size_t)NB * 8 * KEYS * 4);
constexpr size_t WS_END = WS_BCNT + al((size_t)1024 * 8 * 4);
constexpr size_t WS_Y = WS_P;
constexpr size_t WS_HS = WS_OC;
static_assert((size_t)MPAD * D * 4 <= (size_t)MT * NPI * 2 + (size_t)MT * D * 2 + 512, "Y alias");
static_assert((size_t)MPAD * D * 2 <= (size_t)4 * MT * 512 * 4, "HS alias");
constexpr int CW_BAR = 4096;
constexpr int CW_CNT = 8192;
constexpr int CW_CUR = 8192 + 64;
constexpr int CW_PANEL = 8192 + 128;
constexpr int CW_CONV = 12288;
constexpr int CW_CONV0 = 12352;
constexpr int CW_KMAX = 24576;
constexpr int CW_QUEUE = 16384;

constexpr int RING_BYTES = 131072;
constexpr int MISC_OFF = RING_BYTES;
constexpr int LDS_BYTES = 147456;
constexpr int NWAVES = 8, NTHR = 512;

__device__ __forceinline__ float bf2f(bf16 b) { return __uint_as_float(((unsigned)b) << 16); }
__device__ __forceinline__ float bflo(unsigned w) { return __uint_as_float(w << 16); }
__device__ __forceinline__ float bfhi(unsigned w) { return __uint_as_float(w & 0xffff0000u); }
typedef __bf16 bf16x2_t __attribute__((ext_vector_type(2)));
__device__ __forceinline__ unsigned cvt_pk_bf16(float lo, float hi) { const f32x2 v = {lo, hi}; return __builtin_bit_cast(unsigned, __builtin_convertvector(v, bf16x2_t)); }
__device__ __forceinline__ float wave_sum(float v) {
#pragma unroll
    for (int o = 1; o < 64; o <<= 1) v += __shfl_xor(v, o);
    return v;
}
__device__ __forceinline__ unsigned cvt4_fp8(float a, float b, float c, float d) { unsigned w = 0; w = __builtin_amdgcn_cvt_pk_fp8_f32(a, b, w, false); w = __builtin_amdgcn_cvt_pk_fp8_f32(c, d, w, true); return w; }
constexpr float W8_SCALE = 64.0f;
__device__ __forceinline__ float xmax16(float x) { const unsigned u = __float_as_uint(x); const auto r = __builtin_amdgcn_permlane16_swap(u, u, false, false); return fmaxf(__uint_as_float(r[0]), __uint_as_float(r[1])); }
__device__ __forceinline__ float xmax32(float x) { const unsigned u = __float_as_uint(x); const auto r = __builtin_amdgcn_permlane32_swap(u, u, false, false); return fmaxf(__uint_as_float(r[0]), __uint_as_float(r[1])); }
__device__ __forceinline__ float xsum16(float x) { const unsigned u = __float_as_uint(x); const auto r = __builtin_amdgcn_permlane16_swap(u, u, false, false); return __uint_as_float(r[0]) + __uint_as_float(r[1]); }
__device__ __forceinline__ float xsum32(float x) { const unsigned u = __float_as_uint(x); const auto r = __builtin_amdgcn_permlane32_swap(u, u, false, false); return __uint_as_float(r[0]) + __uint_as_float(r[1]); }
__device__ __forceinline__ float fexp2(float x) { return __builtin_amdgcn_exp2f(x); }
__device__ __forceinline__ float fsigmoid(float x) { return 1.0f / (1.0f + __expf(-x)); }
__device__ __forceinline__ float fsilu(float x) { return x / (1.0f + __expf(-x)); }
#define LDS_WAIT() asm volatile("s_waitcnt lgkmcnt(0)" ::: "memory")

#define XB_TMO      128
#define XB_XCNT(j)  (256  + 64 * (j))
#define XB_XSUB(j)  (1280 + 64 * (j))
#define XB_XGEN(j)  (2304 + 64 * (j))
#define XB_TOP      3328
#define XB_TOPGEN   3392
#define XCD_BAR_WORDS 3456
#define XB_SPIN_CAP (1u << 18)
__device__ __forceinline__ unsigned xb_ld(unsigned* p)              { return __hip_atomic_load(p, __ATOMIC_RELAXED, __HIP_MEMORY_SCOPE_AGENT); }
__device__ __forceinline__ unsigned xb_add(unsigned* p, unsigned v) { return __hip_atomic_fetch_add(p, v, __ATOMIC_RELAXED, __HIP_MEMORY_SCOPE_AGENT); }
__device__ __forceinline__ unsigned xb_xcc_id() { return (unsigned)__builtin_amdgcn_s_getreg((3 << 11) | 20) & 0xFu; }
#define XB_SPIN(cond, bar) do { unsigned _sp = 0; while (cond) { __builtin_amdgcn_s_sleep(1); \
    if ((++_sp & 255u) == 0u) { if (xb_ld(&(bar)[XB_TMO])) break; if (_sp > XB_SPIN_CAP) { atomicAdd(&(bar)[XB_TMO], 1u); break; } } } } while (0)
struct XcdBarrier { unsigned* bar; unsigned x; volatile LAS unsigned* st; };
__device__ __forceinline__ XcdBarrier xcd_barrier_post(unsigned* bar, volatile LAS unsigned* st) {
    XcdBarrier b; b.bar = bar; b.x = xb_xcc_id(); b.st = st;
    if (threadIdx.x == 0) (void)xb_add(&bar[XB_XCNT(b.x)], 1u);
    return b;
}
__device__ __forceinline__ void xcd_barrier_complete(unsigned* bar, unsigned x, unsigned& nloc, unsigned& nx) {
    const unsigned G = gridDim.x * gridDim.y * gridDim.z;
    unsigned sum, cnt, mine, sp = 0u;
    for (;;) {
        sum = 0u; cnt = 0u; mine = 0u;
#pragma unroll
        for (unsigned j = 0; j < 16; ++j) { const unsigned c = xb_ld(&bar[XB_XCNT(j)]); sum += c; cnt += (c > 0u) ? 1u : 0u; mine = (j == x) ? c : mine; }
        if (sum == G) break;
        __builtin_amdgcn_s_sleep(1);
        if ((++sp & 255u) == 0u) { if (xb_ld(&bar[XB_TMO])) break; if (sp > XB_SPIN_CAP) { atomicAdd(&bar[XB_TMO], 1u); break; } }
    }
    nloc = mine > 0u ? mine : 1u; nx = cnt > 0u ? cnt : 1u;
}
__device__ __forceinline__ void xcd_barrier(const XcdBarrier& b) {
    asm volatile("s_waitcnt vmcnt(0)" ::: "memory");
    __syncthreads();
    if (threadIdx.x == 0) {
        unsigned* bar = b.bar;
        __builtin_amdgcn_s_waitcnt(0);
        unsigned nloc = b.st[0], nx = b.st[1];
        if (nloc == 0u) { xcd_barrier_complete(bar, b.x, nloc, nx); b.st[0] = nloc; b.st[1] = nx; }
        const unsigned old = xb_add(&bar[XB_XSUB(b.x)], 1u);
        const unsigned gen = old / nloc;
        if (old + 1u == (gen + 1u) * nloc) {
            __builtin_amdgcn_fence(__ATOMIC_RELEASE, "agent");
            asm volatile("s_waitcnt vmcnt(0)" ::: "memory");
            const unsigned og = xb_add(&bar[XB_TOP], 1u);
            const unsigned tg = og / nx;
            if (og + 1u == (tg + 1u) * nx) xb_add(&bar[XB_TOPGEN], 1u);
            else XB_SPIN(xb_ld(&bar[XB_TOPGEN]) == tg, bar);
            __builtin_amdgcn_fence(__ATOMIC_ACQUIRE, "agent");
            xb_add(&bar[XB_XGEN(b.x)], 1u);
            asm volatile("s_waitcnt vmcnt(0)" ::: "memory");
        } else {
            XB_SPIN(xb_ld(&bar[XB_XGEN(b.x)]) == gen, bar);
            __builtin_amdgcn_fence(__ATOMIC_ACQUIRE, "agent");
            asm volatile("s_waitcnt vmcnt(0)" ::: "memory");
        }
    }
    __syncthreads();
}

namespace pg8 {
#define PG8_LAS __attribute__((address_space(3)))
constexpr int BM = 256, BK = 64, HALF = 128, HTB = HALF * BK * 2, STAGE_BYTES = 8 * HTB, NXCD = 8, WGM = 8;
__host__ __device__ __forceinline__ int lds_byte(int r, int c) { const int st = (r >> 4) * 2 + (c >> 5), rr = r & 15, cc = c & 31, ob = rr * 64 + cc * 2; return st * 1024 + (ob ^ (((ob >> 9) & 1) << 5)); }
__host__ __device__ __forceinline__ void stage_rc(int b, int& R, int& C) { const int st = b / 1024, sb = b % 1024, swz = sb ^ (((sb >> 9) & 1) << 5); R = (st >> 1) * 16 + swz / 64; C = (st & 1) * 32 + (swz % 64) / 2; }
__host__ __device__ __forceinline__ int perm32(int rho) { const int n = rho >> 4, i = rho & 15; return 8 * (i >> 2) + 4 * n + (i & 3); }

typedef int i32x4 __attribute__((ext_vector_type(4)));
typedef int i32x8 __attribute__((ext_vector_type(8)));
typedef short s16x16 __attribute__((ext_vector_type(16)));
__device__ __forceinline__ i32x8 cat8(const bf16x8 lo, const bf16x8 hi) { const i32x4 a = __builtin_bit_cast(i32x4, lo), b = __builtin_bit_cast(i32x4, hi); return __builtin_shufflevector(a, b, 0, 1, 2, 3, 4, 5, 6, 7); }
struct Unit { int pm, pn, pb, koff, ks; };
struct Gemm { const bf16* A; const bf16* Bt; int K; int ld; };

struct TileOrder {
    int nM, nN, nwg, G, c;
    __device__ __forceinline__ void init(int nM_, int nN_, int G_, int c_) { nM = nM_; nN = nN_; nwg = nM * nN; G = G_; c = c_; }
    __device__ __forceinline__ bool tile(int i, int& pm, int& pn) const {
        const long L = (long)i * G + c; if (L >= nwg) return false;
        int wgid = (int)L; { const int q = nwg / NXCD, r = nwg % NXCD, xcd = wgid % NXCD, off = wgid / NXCD; wgid = (xcd < r ? xcd * (q + 1) : r * (q + 1) + (xcd - r) * q) + off; }
        const int nig = WGM * nN, gid = wgid / nig, fm = gid * WGM, gsz = (nM - fm) < WGM ? (nM - fm) : WGM;
        pm = fm + ((wgid % nig) % gsz); pn = (wgid % nig) / gsz; return true;
    }
};
struct DenseOrder : TileOrder {
    __device__ __forceinline__ bool next(int i, Unit& u) const { if (!tile(i, u.pm, u.pn)) return false; u.pb = u.pn; u.koff = 0; u.ks = 0; return true; }
    __device__ __forceinline__ void a_ready(const Unit&) const {}
    __device__ __forceinline__ void done(const Unit&) const {}
};
struct MoeOrder : TileOrder {
    const volatile PG8_LAS unsigned char* pe;
    __device__ __forceinline__ bool next(int i, Unit& u) const { if (!tile(i, u.pm, u.pn)) return false; u.pb = (int)pe[u.pm] * nN + u.pn; u.koff = 0; u.ks = 0; return true; }
    __device__ __forceinline__ void a_ready(const Unit&) const {}
    __device__ __forceinline__ void done(const Unit&) const {}
};

struct SplitOrder {
    int pm0, npan, nN, nks, kbytes, G, c; const volatile PG8_LAS unsigned char* pe;
    __device__ __forceinline__ bool next(int i, Unit& u) const {
        const long L = (long)i * G + c; if (L >= (long)npan * nN * nks) return false;
        const int l = (int)L; u.ks = l % nks; const int t = l / nks; u.pn = t % nN; u.pm = pm0 + t / nN; u.koff = u.ks * kbytes;
        u.pb = pe ? (int)pe[u.pm] * nN + u.pn : u.pn; return true;
    }
    __device__ __forceinline__ void a_ready(const Unit&) const {}
    __device__ __forceinline__ void done(const Unit&) const {}
};
struct EpiBf16 {
    static constexpr bool PERM = true, AFTER_DRAIN = false;
    bf16* O; int ldc;
    __device__ __forceinline__ void operator()(const f32x4 (&acc)[2][2][4][2], const Unit& u, int wr, int wc, int fr, int fq) const {
        const int row0 = u.pm * BM + wr * 64 + fr, col0 = u.pn * BM + wc * 32 + 8 * fq;
#pragma unroll
        for (int ai = 0; ai < 2; ++ai)
#pragma unroll
            for (int m = 0; m < 4; ++m) { bf16* rowp = O + (size_t)(row0 + ai * HALF + m * 16) * ldc + col0;
#pragma unroll
                for (int bj = 0; bj < 2; ++bj) { const f32x4 v0 = acc[ai][bj][m][0], v1 = acc[ai][bj][m][1];
                    u32x4 w; w.x = cvt_pk_bf16(v0[0], v0[1]); w.y = cvt_pk_bf16(v0[2], v0[3]); w.z = cvt_pk_bf16(v1[0], v1[1]); w.w = cvt_pk_bf16(v1[2], v1[3]);
                    *(u32x4*)(rowp + bj * HALF) = w; } }
    }
};
struct EpiSwiglu {
    static constexpr bool PERM = true, AFTER_DRAIN = false;
    bf16* O; int ldc;
    __device__ __forceinline__ void operator()(const f32x4 (&acc)[2][2][4][2], const Unit& u, int wr, int wc, int fr, int fq) const {
        const int row0 = u.pm * BM + wr * 64 + fr, col0 = u.pn * HALF + wc * 32 + 8 * fq;
#pragma unroll
        for (int ai = 0; ai < 2; ++ai)
#pragma unroll
            for (int m = 0; m < 4; ++m) { bf16* rowp = O + (size_t)(row0 + ai * HALF + m * 16) * ldc + col0;
                float o[8];
#pragma unroll
                for (int n = 0; n < 2; ++n)
#pragma unroll
                    for (int j = 0; j < 4; ++j) { const float a = acc[ai][0][m][n][j], b = acc[ai][1][m][n][j]; o[n * 4 + j] = a * __builtin_amdgcn_rcpf(1.0f + __expf(-a)) * b; }
                u32x4 w; w.x = cvt_pk_bf16(o[0], o[1]); w.y = cvt_pk_bf16(o[2], o[3]); w.z = cvt_pk_bf16(o[4], o[5]); w.w = cvt_pk_bf16(o[6], o[7]);
                *(u32x4*)rowp = w; }
    }
};
struct EpiSwiglu8 {
    static constexpr bool PERM = true, AFTER_DRAIN = false;
    unsigned char* O; int ldc;
    __device__ __forceinline__ void operator()(const f32x4 (&acc)[2][2][4][2], const Unit& u, int wr, int wc, int fr, int fq) const {
        const int row0 = u.pm * BM + wr * 64 + fr, col0 = u.pn * HALF + wc * 32 + 8 * fq;
#pragma unroll
        for (int ai = 0; ai < 2; ++ai)
#pragma unroll
            for (int m = 0; m < 4; ++m) { unsigned char* rowp = O + (size_t)(row0 + ai * HALF + m * 16) * ldc + col0;
                float o[8];
#pragma unroll
                for (int n = 0; n < 2; ++n)
#pragma unroll
                    for (int j = 0; j < 4; ++j) { const float a = acc[ai][0][m][n][j], b = acc[ai][1][m][n][j]; o[n * 4 + j] = a * __builtin_amdgcn_rcpf(1.0f + __expf(-a)) * b; }
                u32x2 w; w.x = cvt4_fp8(o[0], o[1], o[2], o[3]); w.y = cvt4_fp8(o[4], o[5], o[6], o[7]);
                *(u32x2*)rowp = w; }
    }
};
struct EpiResid {
    static constexpr bool PERM = false, AFTER_DRAIN = false;
    const float* res_lat; const float* res_ctx; float* X; const float* gate;
    __device__ __forceinline__ void operator()(const f32x4 (&acc)[2][2][4][2], const Unit& u, int wr, int wc, int fr, int fq) const {
        const int row0 = u.pm * BM + wr * 64 + fr, col0 = u.pn * BM + wc * 32 + 4 * fq;
        const int ci = u.pm < 32 ? (u.pm >> 3) : 4;
        const float* gp = gate + (size_t)ci * MODW + col0;
        f32x4 gv[2][2];
#pragma unroll
        for (int bj = 0; bj < 2; ++bj)
#pragma unroll
            for (int n = 0; n < 2; ++n) gv[bj][n] = *(const f32x4*)(gp + bj * HALF + n * 16);
#pragma unroll
        for (int ai = 0; ai < 2; ++ai)
#pragma unroll
            for (int m = 0; m < 4; ++m) { const int r = row0 + ai * HALF + m * 16;
                const float* rp = (r < NLAT ? res_lat + (size_t)r * D : res_ctx + (size_t)(r - NLAT) * D) + col0; float* xp = X + (size_t)r * D + col0;
#pragma unroll
                for (int bj = 0; bj < 2; ++bj)
#pragma unroll
                    for (int n = 0; n < 2; ++n) { const f32x4 rv = *(const f32x4*)(rp + bj * HALF + n * 16); *(f32x4*)(xp + bj * HALF + n * 16) = rv + gv[bj][n] * acc[ai][bj][m][n]; } }
    }
};
struct EpiF32 {
    static constexpr bool PERM = false, AFTER_DRAIN = false;
    float* C; int ldc;
    __device__ __forceinline__ void operator()(const f32x4 (&acc)[2][2][4][2], const Unit& u, int wr, int wc, int fr, int fq) const {
        const int row0 = u.pm * BM + wr * 64 + fr, col0 = u.pn * BM + wc * 32 + 4 * fq;
#pragma unroll
        for (int ai = 0; ai < 2; ++ai)
#pragma unroll
            for (int m = 0; m < 4; ++m) { float* rowp = C + (size_t)(row0 + ai * HALF + m * 16) * ldc + col0;
#pragma unroll
                for (int bj = 0; bj < 2; ++bj)
#pragma unroll
                    for (int n = 0; n < 2; ++n) *(f32x4*)(rowp + bj * HALF + n * 16) = acc[ai][bj][m][n]; }
    }
};

struct EpiPart {
    static constexpr bool PERM = false, AFTER_DRAIN = false;
    float* C; int ldc; int pm0; size_t slab;
    __device__ __forceinline__ void operator()(const f32x4 (&acc)[2][2][4][2], const Unit& u, int wr, int wc, int fr, int fq) const {
        const int row0 = (u.pm - pm0) * BM + wr * 64 + fr, col0 = u.pn * BM + wc * 32 + 4 * fq;
        float* base = C + (size_t)u.ks * slab;
#pragma unroll
        for (int ai = 0; ai < 2; ++ai)
#pragma unroll
            for (int m = 0; m < 4; ++m) { float* rowp = base + (size_t)(row0 + ai * HALF + m * 16) * ldc + col0;
#pragma unroll
                for (int bj = 0; bj < 2; ++bj)
#pragma unroll
                    for (int n = 0; n < 2; ++n) *(f32x4*)(rowp + bj * HALF + n * 16) = acc[ai][bj][m][n]; }
    }
};
template <class Epi, class Sched, bool ALIGN_EPI = true, bool SP2 = true, bool FP8 = false>
__device__ __forceinline__ void gemm_phase(PG8_LAS unsigned char* lds, const int tid, const Gemm g, const Sched& S, const Epi& E) {
    const int wid = __builtin_amdgcn_readfirstlane(tid >> 6), lane = tid & 63, wr = wid >> 2, wc = wid & 3, fr = lane & 15, fq = lane >> 4;
    const int K = g.ld, nt = g.K / BK;
    unsigned voffA[2], voffB[2];
#pragma unroll
    for (int i = 0; i < 2; ++i) { int R, C; stage_rc(tid * 16 + i * 8192, R, C); const int Rb = Epi::PERM ? ((R & ~31) + perm32(R & 31)) : R;
        voffA[i] = (unsigned)(R * K + C) * 2u; voffB[i] = (unsigned)(Rb * K + C) * 2u; }
    const size_t kstep = (size_t)(BK * 2);
    const size_t hstep = (size_t)HALF * K * 2;
    const size_t tstep = 2 * hstep;
    const unsigned ldsw = (unsigned)wid * 1024u;
    const int aoff = FP8 ? lds_byte(wr * 64 + fr, fq * 16) : lds_byte(wr * 64 + fr, fq * 8), boff = FP8 ? lds_byte(wc * 32 + fr, fq * 16) : lds_byte(wc * 32 + fr, fq * 8);
#define PG8_SA(b, h) (((b) * 2 + (h)) * HTB)
#define PG8_SB(b, h) ((4 + (b) * 2 + (h)) * HTB)
#define PG8_STAGE(bufoff, gbase, voff) do { _Pragma("unroll") for (int _i = 0; _i < 2; ++_i) \
        __builtin_amdgcn_global_load_lds((const unsigned*)((const char*)(gbase) + (voff)[_i]), (PG8_LAS unsigned*)(lds + (bufoff) + ldsw + _i * 8192), 16, 0, 0); } while (0)
#define PG8_LDA(dst, b, h) do { _Pragma("unroll") for (int m = 0; m < 4; ++m) { if constexpr (FP8) dst[m] = cat8(*(const PG8_LAS bf16x8*)(lds + PG8_SA(b, h) + aoff + m * 2048), *(const PG8_LAS bf16x8*)(lds + PG8_SA(b, h) + aoff + m * 2048 + 16)); \
        else dst[m] = cat8(*(const PG8_LAS bf16x8*)(lds + PG8_SA(b, h) + aoff + m * 2048), *(const PG8_LAS bf16x8*)(lds + PG8_SA(b, h) + aoff + m * 2048 + 1024)); } } while (0)
#define PG8_LDB(dst, b, h) do { _Pragma("unroll") for (int n = 0; n < 2; ++n) { if constexpr (FP8) dst[n] = cat8(*(const PG8_LAS bf16x8*)(lds + PG8_SB(b, h) + boff + n * 2048), *(const PG8_LAS bf16x8*)(lds + PG8_SB(b, h) + boff + n * 2048 + 16)); \
        else dst[n] = cat8(*(const PG8_LAS bf16x8*)(lds + PG8_SB(b, h) + boff + n * 2048), *(const PG8_LAS bf16x8*)(lds + PG8_SB(b, h) + boff + n * 2048 + 1024)); } } while (0)
#define PG8_K0(x) __builtin_bit_cast(bf16x8, __builtin_shufflevector(x, x, 0, 1, 2, 3))
#define PG8_K1(x) __builtin_bit_cast(bf16x8, __builtin_shufflevector(x, x, 4, 5, 6, 7))
#define PG8_MMA(ai, bj, At, Bt) do { __builtin_amdgcn_s_setprio(1); \
        if constexpr (FP8) { _Pragma("unroll") for (int m = 0; m < 4; ++m) _Pragma("unroll") for (int n = 0; n < 2; ++n) \
            asm volatile("v_mfma_scale_f32_16x16x128_f8f6f4 %0, %1, %2, %0, %3, %4 op_sel_hi:[0,0,0]" : "+v"(acc[ai][bj][m][n]) : "v"(Bt[n]), "v"(At[m]), "v"(sc_w), "v"(sc_a)); } \
        else { _Pragma("unroll") for (int m = 0; m < 4; ++m) _Pragma("unroll") for (int n = 0; n < 2; ++n) { \
            acc[ai][bj][m][n] = __builtin_amdgcn_mfma_f32_16x16x32_bf16(PG8_K0(Bt[n]), PG8_K0(At[m]), acc[ai][bj][m][n], 0, 0, 0); \
            acc[ai][bj][m][n] = __builtin_amdgcn_mfma_f32_16x16x32_bf16(PG8_K1(Bt[n]), PG8_K1(At[m]), acc[ai][bj][m][n], 0, 0, 0); } } \
        __builtin_amdgcn_s_setprio(0); } while (0)
#define PG8_WAIT_V(n) asm volatile("s_waitcnt vmcnt(" #n ")" ::: "memory")
#define PG8_WAIT_L(n) asm volatile("s_waitcnt lgkmcnt(" #n ")" ::: "memory")
#define PG8_BAR __builtin_amdgcn_s_barrier()
#define PG8_SCHED __builtin_amdgcn_sched_barrier(0)
    Unit cur, nxt; int ui = 0;
    if (!S.next(0, cur)) return;
    f32x4 acc[2][2][4][2];
#pragma unroll
    for (int a = 0; a < 2; ++a)
#pragma unroll
        for (int b = 0; b < 2; ++b)
#pragma unroll
            for (int m = 0; m < 4; ++m)
#pragma unroll
                for (int n = 0; n < 2; ++n) acc[a][b][m][n] = (f32x4){0.f, 0.f, 0.f, 0.f};
    i32x8 At[4], B0[2], B1[2];
    const int sc_w = 0x79797979, sc_a = 0x7f7f7f7f; (void)sc_w; (void)sc_a;
    const char* cA = (const char*)g.A + (size_t)cur.pm * tstep + cur.koff; const char* cB = (const char*)g.Bt + (size_t)cur.pb * tstep + cur.koff;
    S.a_ready(cur);
    if constexpr (SP2) {
        PG8_STAGE(PG8_SB(0, 0), cB, voffB); PG8_STAGE(PG8_SB(0, 1), cB + hstep, voffB); PG8_STAGE(PG8_SA(0, 0), cA, voffA); PG8_STAGE(PG8_SA(0, 1), cA + hstep, voffA);
        if (wr == 1) PG8_BAR;
        PG8_WAIT_V(2); PG8_BAR;
        PG8_STAGE(PG8_SB(1, 0), cB + kstep, voffB); PG8_STAGE(PG8_SA(1, 0), cA + kstep, voffA); PG8_STAGE(PG8_SB(1, 1), cB + hstep + kstep, voffB);
        PG8_WAIT_V(6); PG8_BAR;
    } else {
        PG8_STAGE(PG8_SB(0, 0), cB, voffB); PG8_STAGE(PG8_SA(0, 0), cA, voffA); PG8_STAGE(PG8_SB(0, 1), cB + hstep, voffB); PG8_STAGE(PG8_SA(0, 1), cA + hstep, voffA);
        if (wr == 1) PG8_BAR;
        PG8_WAIT_V(4); PG8_BAR;
        PG8_STAGE(PG8_SB(1, 0), cB + kstep, voffB); PG8_STAGE(PG8_SA(1, 0), cA + kstep, voffA); PG8_STAGE(PG8_SB(1, 1), cB + hstep + kstep, voffB);
        PG8_WAIT_V(6); PG8_BAR;
    }
    for (;;) {
        const bool has_next = S.next(ui + 1, nxt);
        const char* nA = has_next ? (const char*)g.A + (size_t)nxt.pm * tstep + nxt.koff : cA; const char* nB = has_next ? (const char*)g.Bt + (size_t)nxt.pb * tstep + nxt.koff : cB;
        for (int t = 0; t < nt; t += 2) {
            const bool last = (t == nt - 2);
            const char* a1 = cA + (size_t)(t + 1) * kstep;
            const char* a2 = last ? nA : cA + (size_t)(t + 2) * kstep; const char* b2 = last ? nB : cB + (size_t)(t + 2) * kstep;
            const char* a3 = a2 + kstep; const char* b3 = b2 + kstep;
            if (last && has_next) S.a_ready(nxt);
            if constexpr (SP2) {
            PG8_LDB(B0, 0, 0); PG8_LDB(B1, 0, 1); PG8_SCHED; PG8_LDA(At, 0, 0); PG8_STAGE(PG8_SA(1, 1), a1 + hstep, voffA);
            PG8_WAIT_V(8); PG8_WAIT_L(0); PG8_BAR; PG8_MMA(0, 0, At, B0); PG8_MMA(0, 1, At, B1); PG8_BAR; PG8_SCHED;
            PG8_LDA(At, 0, 1); PG8_STAGE(PG8_SB(0, 0), b2, voffB); PG8_STAGE(PG8_SB(0, 1), b2 + hstep, voffB); PG8_STAGE(PG8_SA(0, 0), a2, voffA);
            PG8_WAIT_V(8); PG8_WAIT_L(0); PG8_BAR; PG8_MMA(1, 0, At, B0); PG8_MMA(1, 1, At, B1); PG8_BAR; PG8_SCHED;
            PG8_LDB(B0, 1, 0); PG8_LDB(B1, 1, 1); PG8_SCHED; PG8_LDA(At, 1, 0); PG8_STAGE(PG8_SA(0, 1), a2 + hstep, voffA);
            PG8_WAIT_V(8); PG8_WAIT_L(0); PG8_BAR; PG8_MMA(0, 0, At, B0); PG8_MMA(0, 1, At, B1); PG8_BAR; PG8_SCHED;
            PG8_LDA(At, 1, 1); PG8_STAGE(PG8_SB(1, 0), b3, voffB); PG8_STAGE(PG8_SB(1, 1), b3 + hstep, voffB); PG8_STAGE(PG8_SA(1, 0), a3, voffA);
            PG8_WAIT_V(8); PG8_WAIT_L(0); PG8_BAR; PG8_MMA(1, 0, At, B0); PG8_MMA(1, 1, At, B1); PG8_BAR; PG8_SCHED;
            } else {
            PG8_LDB(B0, 0, 0); PG8_SCHED; PG8_LDA(At, 0, 0); PG8_STAGE(PG8_SA(1, 1), a1 + hstep, voffA);
            PG8_WAIT_L(8); PG8_BAR; PG8_WAIT_L(0); PG8_MMA(0, 0, At, B0); PG8_BAR; PG8_SCHED;
            PG8_LDB(B1, 0, 1); PG8_STAGE(PG8_SB(0, 0), b2, voffB);
            PG8_BAR; PG8_WAIT_L(0); PG8_MMA(0, 1, At, B1); PG8_BAR;
            PG8_LDA(At, 0, 1); PG8_STAGE(PG8_SA(0, 0), a2, voffA);
            PG8_BAR; PG8_WAIT_L(0); PG8_MMA(1, 0, At, B0); PG8_BAR; PG8_SCHED;
            PG8_STAGE(PG8_SB(0, 1), b2 + hstep, voffB);
            PG8_WAIT_V(6); PG8_BAR; PG8_MMA(1, 1, At, B1); PG8_BAR;
            PG8_LDB(B0, 1, 0); PG8_SCHED; PG8_LDA(At, 1, 0); PG8_STAGE(PG8_SA(0, 1), a2 + hstep, voffA);
            PG8_WAIT_L(8); PG8_BAR; PG8_WAIT_L(0); PG8_MMA(0, 0, At, B0); PG8_BAR; PG8_SCHED;
            PG8_LDB(B1, 1, 1); PG8_STAGE(PG8_SB(1, 0), b3, voffB);
            PG8_BAR; PG8_WAIT_L(0); PG8_MMA(0, 1, At, B1); PG8_BAR;
            PG8_LDA(At, 1, 1); PG8_STAGE(PG8_SA(1, 0), a3, voffA);
            PG8_BAR; PG8_WAIT_L(0); PG8_MMA(1, 0, At, B0); PG8_BAR; PG8_SCHED;
            PG8_STAGE(PG8_SB(1, 1), b3 + hstep, voffB);
            PG8_WAIT_V(6); PG8_BAR; PG8_MMA(1, 1, At, B1); PG8_BAR;
            }
        }
        if constexpr (ALIGN_EPI) { if (wr == 0) PG8_BAR; }
        if constexpr (FP8) asm volatile("s_nop 15\n\ts_nop 15" ::: "memory");
        if constexpr (!Epi::AFTER_DRAIN) { E(acc, cur, wr, wc, fr, fq); S.done(cur); }
        if (!has_next) break;
#pragma unroll
        for (int a = 0; a < 2; ++a)
#pragma unroll
            for (int b = 0; b < 2; ++b)
#pragma unroll
                for (int m = 0; m < 4; ++m)
#pragma unroll
                    for (int n = 0; n < 2; ++n) acc[a][b][m][n] = (f32x4){0.f, 0.f, 0.f, 0.f};
        cur = nxt; cA = nA; cB = nB; ++ui;
        if constexpr (ALIGN_EPI) { if (wr == 1) PG8_BAR; }
    }
    PG8_WAIT_V(0);
    if constexpr (!ALIGN_EPI) { if (wr == 0) PG8_BAR; }
    PG8_BAR;
#undef PG8_SA
#undef PG8_SB
#undef PG8_STAGE
#undef PG8_LDA
#undef PG8_LDB
#undef PG8_K0
#undef PG8_K1
#undef PG8_MMA
#undef PG8_WAIT_V
#undef PG8_WAIT_L
#undef PG8_BAR
#undef PG8_SCHED
}
}

struct Params { const float* in[26]; float* out; unsigned char* ws; int ph_lo, ph_hi; };
enum { I_X = 0, I_C, I_CTX, I_CCTX, I_ADAW, I_ADAB, I_NMIX, I_NFFN, I_WIN, I_WOUT, I_DLAM, I_DNORM, I_RELB, I_HLB, I_HNORM, I_GW2, I_GB, I_GNORM,
       I_FW1, I_FW3, I_FW2, I_ROUTER, I_MW1, I_MW3, I_MW2, I_FNORM };

struct Frame { LAS unsigned char* lds; int tid, lane, wave, G, bid; };
typedef const __attribute__((address_space(4))) Params* KP;
__device__ __forceinline__ KP launder_kp(KP k) { asm volatile("" : "+s"(k)); return k; }
__device__ __forceinline__ Frame make_frame(LAS unsigned char* lds) {
    Frame F; F.lds = lds; int t = threadIdx.x; asm volatile("" : "+v"(t)); F.tid = t; F.lane = t & 63; F.wave = __builtin_amdgcn_readfirstlane(t >> 6); F.G = gridDim.x; F.bid = blockIdx.x; return F;
}

__device__ __forceinline__ int row_ci(int m) { return m < NLAT ? (m >> 11) : 4; }

struct CvDesc { const float* src; unsigned char* dst; int nsrc, pitch, out8; };
__device__ __forceinline__ CvDesc conv_desc(const float* W0, const float* W1, int K, int Nsrc, void* WT, int Ndst, int type, int item, int out8, int lane) {
    const int nblk = Ndst / 128, kb = item / nblk, nb = item % nblk, n0 = 128 * nb, k0 = 64 * kb;
    const float* W = W0; int sc = n0;
    if (type == 1) sc = n0 < Z_SRC ? n0 : n0 + 32;
    if (type == 2) { W = (nb & 1) ? W1 : W0; sc = 128 * (nb >> 1); }
    CvDesc d; d.src = W + (size_t)(k0 + 32 * (lane >> 5)) * Nsrc + sc + 4 * (lane & 31); d.nsrc = Nsrc; d.out8 = out8;
    d.pitch = out8 ? K : 2 * K; d.dst = (unsigned char*)WT + (size_t)n0 * d.pitch + (out8 ? k0 : 2 * k0);
    return d;
}
__device__ __forceinline__ void conv_ld16(const float* s, int nsrc, f32x4 (&r)[16]) {
#pragma unroll
    for (int kk = 0; kk < 16; ++kk) { r[kk] = __builtin_nontemporal_load((const f32x4*)s); s += nsrc; }
}
__device__ __forceinline__ void conv_put16(const CvDesc& d, LAS unsigned char* scr, int step, const f32x4 (&r)[16], int lane) {
    const int h = lane >> 5, c = lane & 31;
#pragma unroll
    for (int q = 0; q < 4; ++q) {
        const int rho = 32 * q + c;
        if (d.out8) { u32x4 w;
            w.x = cvt4_fp8(r[0][q] * W8_SCALE, r[1][q] * W8_SCALE, r[2][q] * W8_SCALE, r[3][q] * W8_SCALE);     w.y = cvt4_fp8(r[4][q] * W8_SCALE, r[5][q] * W8_SCALE, r[6][q] * W8_SCALE, r[7][q] * W8_SCALE);
            w.z = cvt4_fp8(r[8][q] * W8_SCALE, r[9][q] * W8_SCALE, r[10][q] * W8_SCALE, r[11][q] * W8_SCALE);   w.w = cvt4_fp8(r[12][q] * W8_SCALE, r[13][q] * W8_SCALE, r[14][q] * W8_SCALE, r[15][q] * W8_SCALE);
            *(LAS u32x4*)(scr + rho * 64 + (((2 * h + step) ^ ((rho >> 2) & 3)) * 16)) = w; }
        else { u32x4 w0, w1; const int p0 = 4 * h + 2 * step;
            w0.x = cvt_pk_bf16(r[0][q], r[1][q]); w0.y = cvt_pk_bf16(r[2][q], r[3][q]);   w0.z = cvt_pk_bf16(r[4][q], r[5][q]);   w0.w = cvt_pk_bf16(r[6][q], r[7][q]);
            w1.x = cvt_pk_bf16(r[8][q], r[9][q]); w1.y = cvt_pk_bf16(r[10][q], r[11][q]); w1.z = cvt_pk_bf16(r[12][q], r[13][q]); w1.w = cvt_pk_bf16(r[14][q], r[15][q]);
            *(LAS u32x4*)(scr + rho * 128 + ((p0 ^ (rho & 7)) * 16)) = w0; *(LAS u32x4*)(scr + rho * 128 + (((p0 + 1) ^ (rho & 7)) * 16)) = w1; }
    }
}
__device__ __forceinline__ void conv_flush(const CvDesc& d, const LAS unsigned char* scr, int lane) {
    if (d.out8) { const int j = lane & 3;
#pragma unroll
        for (int t = 0; t < 8; ++t) { const int rho = (lane >> 2) + 16 * t, n = 4 * (rho & 31) + (rho >> 5);
            const u32x4 w = *(const LAS u32x4*)(scr + rho * 64 + ((j ^ ((rho >> 2) & 3)) * 16));
            __builtin_nontemporal_store(w, (u32x4*)(d.dst + (size_t)n * d.pitch + 16 * j)); } }
    else { const int j = lane & 7;
#pragma unroll
        for (int t = 0; t < 16; ++t) { const int rho = (lane >> 3) + 8 * t, n = 4 * (rho & 31) + (rho >> 5);
            const u32x4 w = *(const LAS u32x4*)(scr + rho * 128 + ((j ^ (rho & 7)) * 16));
            __builtin_nontemporal_store(w, (u32x4*)(d.dst + (size_t)n * d.pitch + 16 * j)); } }
}
template <class DescFn>
__device__ __forceinline__ void conv_items(DescFn desc, int first, int stride, int n, LAS unsigned char* scr, int lane) {
    CvDesc d = desc(first);
    f32x4 ra[16], rb[16];
    conv_ld16(d.src, d.nsrc, ra);
    for (int t = 0; t < n; ++t) {
        const bool has = t + 1 < n;
        CvDesc nd = d; if (has) nd = desc(first + stride * (t + 1));
        conv_ld16(d.src + (size_t)16 * d.nsrc, d.nsrc, rb);
        conv_put16(d, scr, 0, ra, lane);
        if (has) conv_ld16(nd.src, nd.nsrc, ra);
        conv_put16(d, scr, 1, rb, lane);
        conv_flush(d, scr, lane);
        d = nd;
    }
}
template <int BATCH, class DescFn>
__device__ __forceinline__ void conv_queue(const Frame& F, unsigned* ctr, int limit, int total, DescFn desc) {
    volatile LAS int* slot = (volatile LAS int*)(F.lds + MISC_OFF + 128);
    __syncthreads();
    for (;;) {
        if (F.tid == 0) {
            int st = -1;
            if (__hip_atomic_load(ctr, __ATOMIC_RELAXED, __HIP_MEMORY_SCOPE_AGENT) < (unsigned)limit) st = (int)__hip_atomic_fetch_add(ctr, (unsigned)BATCH, __ATOMIC_RELAXED, __HIP_MEMORY_SCOPE_AGENT);
            *slot = st;
        }
        __syncthreads();
        const int start = *slot;
        if (start < 0 || start >= total) break;
        conv_items(desc, start + F.wave, NWAVES, BATCH / NWAVES, F.lds + F.wave * 16384, F.lane);
        __syncthreads();
    }
    __syncthreads();
}

constexpr int CV_IN = (D / 64) * (NPI / 128), CV_OUT = (D / 64) * (D / 128), CV_13 = (D / 64) * (2 * FFD / 128), CV_2 = (FFD / 64) * (D / 128),
              CV_13E = (D / 64) * (2 * FFE / 128), CV_2E = (FFE / 64) * (D / 128);
constexpr int CV_P0_ITEMS = CV_IN + CV_OUT + CV_13 + CV_2;
constexpr int CV_L1_ITEMS = CV_IN + CV_OUT;
constexpr int CV_DEF_ITEMS = CV_L1_ITEMS + NEXP * CV_13E + NEXP * CV_2E;
constexpr int FFU_GEMM_WGS = 176, CV_FFU_ITEMS = NEXP * CV_13E;
__device__ __forceinline__ CvDesc conv_p0_desc(KP p, int it, int lane) {
    unsigned char* ws = p->ws; int r = it;
    if (r < CV_IN) return conv_desc(p->in[I_WIN], nullptr, D, INW, ws + WS_WIN, NPI, 1, r, 0, lane);
    r -= CV_IN;
    if (r < CV_OUT) return conv_desc(p->in[I_WOUT], nullptr, D, D, ws + WS_WOUT, D, 0, r, 0, lane);
    r -= CV_OUT;
    if (r < CV_13) return conv_desc(p->in[I_FW1], p->in[I_FW3], D, FFD, ws + WS_W13, 2 * FFD, 2, r, 0, lane);
    r -= CV_13;
    return conv_desc(p->in[I_FW2], nullptr, FFD, D, ws + WS_W2, D, 0, r, 1, lane);
}
__device__ __forceinline__ CvDesc conv_def_desc(KP p, int it, int lane) {
    unsigned char* ws = p->ws; int r = it;
    if (r < CV_IN) return conv_desc(p->in[I_WIN] + (size_t)D * INW, nullptr, D, INW, (bf16*)(ws + WS_WIN) + (size_t)NPI * D, NPI, 1, r, 0, lane);
    r -= CV_IN;
    if (r < CV_OUT) return conv_desc(p->in[I_WOUT] + (size_t)D * D, nullptr, D, D, (bf16*)(ws + WS_WOUT) + (size_t)D * D, D, 0, r, 0, lane);
    r -= CV_OUT;
    if (r < NEXP * CV_13E) { const int e = r / CV_13E; r -= e * CV_13E;
        return conv_desc(p->in[I_MW1] + (size_t)e * D * FFE, p->in[I_MW3] + (size_t)e * D * FFE, D, FFE, ws + WS_W13E + (size_t)e * 2 * FFE * D, 2 * FFE, 2, r, 1, lane); }
    r -= NEXP * CV_13E;
    { const int e = r / CV_2E; r -= e * CV_2E;
        return conv_desc(p->in[I_MW2] + (size_t)e * FFE * D, nullptr, FFE, D, ws + WS_W2E + (size_t)e * D * FFE, D, 0, r, 1, lane); }
}
__device__ __forceinline__ void conv_drain(KP p, const Frame& F, int limit) {
    const int lane = F.lane;
    conv_queue<16>(F, (unsigned*)(p->ws + WS_CTL) + CW_CONV, limit, CV_DEF_ITEMS, [&](int it) { return conv_def_desc(p, it, lane); });
}
__device__ __forceinline__ void p0_prologue(KP p, const Frame& F) {
    unsigned char* ws = p->ws;
    {
        LAS float* cond = (LAS float*)F.lds;
        LAS float* red = (LAS float*)(F.lds + 65536);
        for (int k = F.tid; k < D; k += NTHR) {
#pragma unroll
            for (int ci = 0; ci < 4; ++ci) cond[k * 8 + ci] = fsilu(p->in[I_C][ci * D + k]);
            cond[k * 8 + 4] = fsilu(p->in[I_CCTX][k]); cond[k * 8 + 5] = 0.f; cond[k * 8 + 6] = 0.f; cond[k * 8 + 7] = 0.f;
        }
        __syncthreads();
        float* MOD = (float*)(ws + WS_MOD);
        constexpr int AC = 48;
        for (int it = F.bid; it < 2 * (MODW / AC); it += F.G) {
            const int l = it / (MODW / AC), n0 = (it % (MODW / AC)) * AC;
            const bool act = F.lane < AC;
            const float* w = p->in[I_ADAW] + (size_t)l * D * MODW + n0 + (act ? F.lane : 0);
            float a0 = 0.f, a1 = 0.f, a2 = 0.f, a3 = 0.f, a4 = 0.f;
            const int kb = F.wave * 256;
            for (int k0 = kb; k0 < kb + 256; k0 += 16) {
                float wv[16];
#pragma unroll
                for (int u = 0; u < 16; ++u) wv[u] = w[(size_t)(k0 + u) * MODW];
#pragma unroll
                for (int u = 0; u < 16; ++u) { const f32x4 c4 = *(const LAS f32x4*)(cond + (k0 + u) * 8); const float c5 = cond[(k0 + u) * 8 + 4];
                    a0 += c4[0] * wv[u]; a1 += c4[1] * wv[u]; a2 += c4[2] * wv[u]; a3 += c4[3] * wv[u]; a4 += c5 * wv[u]; }
            }
            red[(F.wave * 5 + 0) * 64 + F.lane] = a0; red[(F.wave * 5 + 1) * 64 + F.lane] = a1; red[(F.wave * 5 + 2) * 64 + F.lane] = a2;
            red[(F.wave * 5 + 3) * 64 + F.lane] = a3; red[(F.wave * 5 + 4) * 64 + F.lane] = a4;
            __syncthreads();
            if (F.tid < 320) { const int ci = F.tid / 64, ln = F.tid % 64;
                if (ln < AC) { float s = p->in[I_ADAB][(size_t)l * MODW + n0 + ln];
#pragma unroll
                    for (int w8 = 0; w8 < 8; ++w8) s += red[(w8 * 5 + ci) * 64 + ln];
                    MOD[((size_t)l * 5 + ci) * MODW + n0 + ln] = s; } }
            __syncthreads();
        }
    }
    __syncthreads();
    {
        bf16* WZT = (bf16*)(ws + WS_WZT);
        for (int i = F.bid * NTHR + F.tid; i < 2 * 32 * D; i += F.G * NTHR) { const int l = i / (32 * D), r = i % (32 * D), zc = r / D, k = r % D;
            WZT[i] = (bf16)(cvt_pk_bf16(p->in[I_WIN][((size_t)l * D + k) * INW + Z_SRC + zc], 0.f) & 0xffffu); }
    }
    { const int lane = F.lane;
      conv_queue<8>(F, (unsigned*)(ws + WS_CTL) + CW_CONV0, CV_P0_ITEMS, CV_P0_ITEMS, [&](int it) { return conv_p0_desc(p, it, lane); }); }
}

template <bool ROUTE, bool OUT8 = false, int CTXP = 0>
__device__ __forceinline__ void norm_phase(KP p, const Frame& F, int l, bool first_layer_src, const float* gain, int shift_chunk, int scale_chunk, int nrows) {
    unsigned char* ws = p->ws;
    const float* MOD = (const float*)(ws + WS_MOD) + (size_t)l * 5 * MODW;
    const float* X = (const float*)(ws + WS_X);
    bf16* H = (bf16*)(ws + WS_H);
    const int gw = F.bid * NWAVES + F.wave, NGW = F.G * NWAVES;
    volatile LAS unsigned* rcnt = (volatile LAS unsigned*)(F.lds + MISC_OFF + 512);
    if constexpr (ROUTE) {
        if (F.tid < 8) rcnt[F.tid] = 0u;
        const f32x4* rsrc = (const f32x4*)p->in[I_ROUTER]; LAS f32x4* rdst = (LAS f32x4*)F.lds;
        for (int i = F.tid; i < D * 8 / 4; i += NTHR) rdst[i] = rsrc[i];
        __syncthreads(); }
    for (int m = gw; m < nrows; m += NGW) {
        const float* src = first_layer_src ? (m < NLAT ? p->in[I_X] + (size_t)m * D : p->in[I_CTX] + (size_t)(m - NLAT) * D) : X + (size_t)m * D;
        const int ci = row_ci(m);
        const f32x4* xr = (const f32x4*)src + F.lane;
        f32x4 v[8]; float ss = 0.f;
#pragma unroll
        for (int j = 0; j < 8; ++j) v[j] = xr[64 * j];
        if (CTXP == 1 && m >= NLAT) {
            const f32x4* gq = (const f32x4*)((const float*)(ws + WS_MOD) + (size_t)(l - 1) * 5 * MODW + (size_t)4 * MODW + 5 * D) + F.lane;
            const f32x4* pp = (const f32x4*)((const float*)(ws + WS_SPLIT) + (size_t)(m - NLAT) * D) + F.lane;
#pragma unroll
            for (int j = 0; j < 8; ++j) { f32x4 a = pp[64 * j];
#pragma unroll
                for (int ks = 1; ks < FFD_KS; ++ks) a = a + pp[(size_t)ks * NCTX * D / 4 + 64 * j];
                v[j] = v[j] + gq[64 * j] * a; }
        }
        if (CTXP == 2 && m >= NLAT) {
            const f32x4* cin = (const f32x4*)(p->in[I_CTX] + (size_t)(m - NLAT) * D) + F.lane;
            const f32x4* gq = (const f32x4*)((const float*)(ws + WS_MOD) + (size_t)l * 5 * MODW + (size_t)4 * MODW + 2 * D) + F.lane;
            const f32x4* pp = (const f32x4*)((const float*)(ws + WS_SPLIT) + (size_t)(m - NLAT) * D) + F.lane;
            f32x4* xo = (f32x4*)((float*)(ws + WS_X) + (size_t)m * D) + F.lane;
#pragma unroll
            for (int j = 0; j < 8; ++j) { f32x4 a = pp[64 * j];
#pragma unroll
                for (int ks = 1; ks < OUT_KS; ++ks) a = a + pp[(size_t)ks * NCTX * D / 4 + 64 * j];
                v[j] = cin[64 * j] + gq[64 * j] * a; xo[64 * j] = v[j]; }
        }
#pragma unroll
        for (int j = 0; j < 8; ++j) ss += (v[j][0] * v[j][0] + v[j][1] * v[j][1]) + (v[j][2] * v[j][2] + v[j][3] * v[j][3]);
        const float rstd = 1.0f / sqrtf(wave_sum(ss) * (1.0f / D) + NORM_EPS);
        const f32x4* gp = (const f32x4*)gain + F.lane;
        const f32x4* shp = (const f32x4*)(MOD + (size_t)ci * MODW + shift_chunk * D) + F.lane;
        const f32x4* scp = (const f32x4*)(MOD + (size_t)ci * MODW + scale_chunk * D) + F.lane;
        u32x2* o8 = (u32x2*)(H + (size_t)m * D) + F.lane;
        unsigned* o4 = (unsigned*)((unsigned char*)H + (size_t)m * D) + F.lane;
#pragma unroll
        for (int j = 0; j < 8; ++j) { const f32x4 gg = gp[64 * j], sh = shp[64 * j], sc = scp[64 * j];
            v[j] = v[j] * rstd * gg * (sc + 1.0f) + sh;
            if (OUT8) o4[64 * j] = cvt4_fp8(v[j][0], v[j][1], v[j][2], v[j][3]);
            else { u32x2 w; w.x = cvt_pk_bf16(v[j][0], v[j][1]); w.y = cvt_pk_bf16(v[j][2], v[j][3]); o8[64 * j] = w; } }
        if constexpr (ROUTE) {
            const LAS float* rw = (const LAS float*)F.lds;
            float lg[8];
#pragma unroll
            for (int e = 0; e < 8; ++e) lg[e] = 0.f;
#pragma unroll
            for (int j = 0; j < 8; ++j)
#pragma unroll
                for (int q = 0; q < 4; ++q) { const int c = 256 * j + 4 * F.lane + q; const f32x4 r0 = *(const LAS f32x4*)(rw + c * 8), r1 = *(const LAS f32x4*)(rw + c * 8 + 4); const float y = v[j][q];
                    lg[0] += y * r0[0]; lg[1] += y * r0[1]; lg[2] += y * r0[2]; lg[3] += y * r0[3]; lg[4] += y * r1[0]; lg[5] += y * r1[1]; lg[6] += y * r1[2]; lg[7] += y * r1[3]; }
#pragma unroll
            for (int e = 0; e < 8; ++e) lg[e] = wave_sum(lg[e]);
            if (F.lane == 0) {
                int i0 = 0; float v0 = lg[0];
#pragma unroll
                for (int e = 1; e < 8; ++e) if (lg[e] > v0) { v0 = lg[e]; i0 = e; }
                int i1 = -1; float v1 = -3.0e38f;
#pragma unroll
                for (int e = 0; e < 8; ++e) if (e != i0 && lg[e] > v1) { v1 = lg[e]; i1 = e; }
                const float w0 = 1.0f / (1.0f + __expf(v1 - v0)), w1 = 1.0f - w0;
                unsigned* rt = (unsigned*)(ws + WS_ROUTE) + (size_t)m * 4;
                rt[0] = (unsigned)i0; rt[1] = (unsigned)i1; rt[2] = __float_as_uint(w0); rt[3] = __float_as_uint(w1);
                __hip_atomic_fetch_add((LAS unsigned*)(rcnt + i0), 1u, __ATOMIC_RELAXED, __HIP_MEMORY_SCOPE_WORKGROUP);
                __hip_atomic_fetch_add((LAS unsigned*)(rcnt + i1), 1u, __ATOMIC_RELAXED, __HIP_MEMORY_SCOPE_WORKGROUP);
            }
        }
    }
    if constexpr (ROUTE) { __syncthreads(); if (F.tid < 8) ((unsigned*)(ws + WS_BCNT))[(size_t)F.bid * 8 + F.tid] = rcnt[F.tid]; }
}

__device__ __forceinline__ void prep_phase(KP p, const Frame& F, int l, bool ctx_out, int parts = 15, size_t wofs = 0  ) {
    unsigned char* ws = p->ws;
    bf16* P = (bf16*)(ws + WS_P);
    const int gw = F.bid * NWAVES + F.wave, NGW = F.G * NWAVES;
    const int lane = F.lane;
    if (parts & 1) {
        const float qs = 0.17677669529663687f * LOG2E;
        float* kna = (float*)(ws + WS_KNA); float* knb = (float*)(ws + WS_KNB);
        for (int m = gw; m < MT; m += NGW) {
            bf16* row = P + (size_t)m * NPI; bf16* wrow = row + wofs;
            const int b = m < NLAT ? (m >> 11) : ((m - NLAT) >> 8);
            const int key = m < NLAT ? (CTXL + (m & (SEQ - 1))) : ((m - NLAT) & (CTXL - 1));
            if (m < NLAT) {
                const int t = m & (SEQ - 1), i = lane & 15;
                const float pos = (i < 8) ? (float)(t >> 6) : (float)(t & 63);
                const float inv = exp2f(-(float)(i & 7) * (13.287712379549449f / 8.0f));
                float sn, cs; sincosf(pos * inv, &sn, &cs);
#pragma unroll
                for (int c = 0; c < 8; ++c) {
                    const int combo = (lane >> 4) + 4 * c;
                    const int base = (combo >> 4) * 512 + (combo & 15) * 32;
                    const float x1 = bf2f(row[base + i]), x2 = bf2f(row[base + 16 + i]);
                    float y1 = x1 * cs - x2 * sn, y2 = x1 * sn + x2 * cs;
                    if (combo < 16) { y1 *= qs; y2 *= qs; }
                    const unsigned w = cvt_pk_bf16(y1, y2);
                    wrow[base + i] = (bf16)(w & 0xffffu); wrow[base + 16 + i] = (bf16)(w >> 16);
                    if (c >= 4) { float n2 = y1 * y1 + y2 * y2; n2 += __shfl_xor(n2, 1); n2 += __shfl_xor(n2, 2); n2 += __shfl_xor(n2, 4); n2 += __shfl_xor(n2, 8);
                        if (i == 0) kna[((size_t)b * 16 + (combo & 15)) * KEYS + key] = n2; }
                }
            } else {
#pragma unroll
                for (int c = 0; c < 8; ++c) { const int idx = lane + 64 * c;
                    if (ctx_out) { const unsigned w = cvt_pk_bf16(bf2f(row[idx]) * qs, 0.f); wrow[idx] = (bf16)(w & 0xffffu); }
                    const float kv = bf2f(row[512 + idx]); float n2 = kv * kv;
                    n2 += __shfl_xor(n2, 1); n2 += __shfl_xor(n2, 2); n2 += __shfl_xor(n2, 4); n2 += __shfl_xor(n2, 8); n2 += __shfl_xor(n2, 16);
                    if ((lane & 31) == 0) kna[((size_t)b * 16 + 2 * c + (lane >> 5)) * KEYS + key] = n2; }
            }
            { const u32x4 w = *(const u32x4*)(row + B_K + 8 * lane);
              float n2 = (bflo(w.x) * bflo(w.x) + bfhi(w.x) * bfhi(w.x)) + (bflo(w.y) * bflo(w.y) + bfhi(w.y) * bfhi(w.y)) + (bflo(w.z) * bflo(w.z) + bfhi(w.z) * bfhi(w.z)) + (bflo(w.w) * bflo(w.w) + bfhi(w.w) * bfhi(w.w));
              n2 += __shfl_xor(n2, 1); n2 += __shfl_xor(n2, 2); n2 += __shfl_xor(n2, 4);
              if ((lane & 7) == 0) knb[((size_t)b * 8 + (lane >> 3)) * KEYS + key] = n2; }
        }
    }
    if (parts & 2) {
        const int nitems = 2 * NB * 8 * (KEYS / 64);
        for (int it = gw; it < nitems; it += NGW) {
            const int mix = it / (NB * 8 * (KEYS / 64)); int r = it % (NB * 8 * (KEYS / 64));
            const int b = r / (8 * (KEYS / 64)); r %= 8 * (KEYS / 64); const int h = r / (KEYS / 64), kc = r % (KEYS / 64);
            const int key = kc * 64 + lane;
            const size_t srow = key < CTXL ? (size_t)(NLAT + b * CTXL + key) : (size_t)(b * SEQ + key - CTXL);
            const u32x4* src = (const u32x4*)(P + srow * NPI + (mix ? B_V : A_V) + h * 64);
            bf16* dst = (bf16*)(ws + (mix ? WS_VTB : WS_VTA)) + ((size_t)(b * 8 + h) * 64) * KEYS + key;
#pragma unroll
            for (int q = 0; q < 8; ++q) { const u32x4 w = src[q];
                dst[(size_t)(8 * q + 0) * KEYS] = (bf16)(w.x & 0xffffu); dst[(size_t)(8 * q + 1) * KEYS] = (bf16)(w.x >> 16);
                dst[(size_t)(8 * q + 2) * KEYS] = (bf16)(w.y & 0xffffu); dst[(size_t)(8 * q + 3) * KEYS] = (bf16)(w.y >> 16);
                dst[(size_t)(8 * q + 4) * KEYS] = (bf16)(w.z & 0xffffu); dst[(size_t)(8 * q + 5) * KEYS] = (bf16)(w.z >> 16);
                dst[(size_t)(8 * q + 6) * KEYS] = (bf16)(w.w & 0xffffu); dst[(size_t)(8 * q + 7) * KEYS] = (bf16)(w.w >> 16); }
        }
    }
    if (parts & 4) {
        float* HLA = (float*)(ws + WS_HLA);
        const int c0 = 8 * lane;
        float lbv[2][8];
#pragma unroll
        for (int dir = 0; dir < 2; ++dir)
#pragma unroll
            for (int j = 0; j < 8; ++j) { float lb = 0.f;
                if (l > 0) { const float h0 = p->in[I_HLB][((size_t)dir * 2 + 0) * 512 + c0 + j], h1 = p->in[I_HLB][((size_t)dir * 2 + 1) * 512 + c0 + j]; lb = fminf(fmaxf(1.0f / (1.0f + __expf(h0 - h1)), 0.f), 1.0f - 1e-6f); }
                lbv[dir][j] = lb; }
        auto gates = [&](bf16* wrow, int m, u32x4 wq, u32x4 wf0, u32x4 wf1) {
            { float x[8] = {bflo(wq.x), bfhi(wq.x), bflo(wq.y), bfhi(wq.y), bflo(wq.z), bfhi(wq.z), bflo(wq.w), bfhi(wq.w)};
#pragma unroll
              for (int j = 0; j < 8; ++j) x[j] = fsilu(x[j]);
              u32x4 w; w.x = cvt_pk_bf16(x[0], x[1]); w.y = cvt_pk_bf16(x[2], x[3]); w.z = cvt_pk_bf16(x[4], x[5]); w.w = cvt_pk_bf16(x[6], x[7]); *(u32x4*)(wrow + C_Q + c0) = w; }
#pragma unroll
            for (int dir = 0; dir < 2; ++dir) {
                const int fcol = (dir ? C_FB : C_FF) + c0;
                u32x4 w = dir ? wf1 : wf0; float x[8] = {bflo(w.x), bfhi(w.x), bflo(w.y), bfhi(w.y), bflo(w.z), bfhi(w.z), bflo(w.w), bfhi(w.w)};
                float la[8], kk[8];
#pragma unroll
                for (int j = 0; j < 8; ++j) {
                    const float lb = lbv[dir][j];
                    const float sg = fsigmoid(x[j]); const float a = lb + (1.0f - lb) * sg;
                    la[j] = fmaxf(__logf(a), -60.0f); kk[j] = (1.0f - lb) * (1.0f - sg);
                }
                w.x = cvt_pk_bf16(kk[0], kk[1]); w.y = cvt_pk_bf16(kk[2], kk[3]); w.z = cvt_pk_bf16(kk[4], kk[5]); w.w = cvt_pk_bf16(kk[6], kk[7]); *(u32x4*)(wrow + fcol) = w;
                float* hp = HLA + ((size_t)dir * MT + m) * 512 + c0;
                *(f32x4*)hp = (f32x4){la[0], la[1], la[2], la[3]}; *(f32x4*)(hp + 4) = (f32x4){la[4], la[5], la[6], la[7]};
            } };
        for (int m = gw; m < MT; m += 2 * NGW) {
            const int mb = m + NGW; const bool hasb = mb < MT;
            bf16* rowa = P + (size_t)m * NPI; bf16* rowb = P + (size_t)(hasb ? mb : m) * NPI;
            const u32x4 qa = *(const u32x4*)(rowa + C_Q + c0), fa0 = *(const u32x4*)(rowa + C_FF + c0), fa1 = *(const u32x4*)(rowa + C_FB + c0);
            const u32x4 qb = *(const u32x4*)(rowb + C_Q + c0), fb0 = *(const u32x4*)(rowb + C_FF + c0), fb1 = *(const u32x4*)(rowb + C_FB + c0);
            gates(rowa + wofs, m, qa, fa0, fa1);
            if (hasb) gates(rowb + wofs, mb, qb, fb0, fb1);
        }
    }
    if (parts & 8) {
        const bf16* H = (const bf16*)(ws + WS_H);
        const bf16* WZT = (const bf16*)(ws + WS_WZT) + (size_t)l * 32 * D;
        const int fr = lane & 15, g = lane >> 4;
        const int nit = (MT / 16 - F.bid + F.G - 1) / F.G;
        LAS float* part = (LAS float*)F.lds;
        LAS float* zfin = (LAS float*)(F.lds + 3 * 16384);
        for (int j = 0; j < nit; ++j) {
            const int row0 = (F.bid + j * F.G) * 16;
            f32x4 a0 = {0.f, 0.f, 0.f, 0.f}, a1 = {0.f, 0.f, 0.f, 0.f};
            const bf16* hp = H + (size_t)(row0 + fr) * D + 8 * g + F.wave * 256; const bf16* w0 = WZT + (size_t)fr * D + 8 * g + F.wave * 256; const bf16* w1 = WZT + (size_t)(16 + fr) * D + 8 * g + F.wave * 256;
#pragma unroll
            for (int ks = 0; ks < 8; ++ks) {
                const bf16x8 av = *(const bf16x8*)(hp + ks * 32), b0 = *(const bf16x8*)(w0 + ks * 32), b1 = *(const bf16x8*)(w1 + ks * 32);
                a0 = __builtin_amdgcn_mfma_f32_16x16x32_bf16(av, b0, a0, 0, 0, 0);
                a1 = __builtin_amdgcn_mfma_f32_16x16x32_bf16(av, b1, a1, 0, 0, 0);
            }
            LAS float* zt = part + (j * 8 + F.wave) * 512;
#pragma unroll
            for (int r = 0; r < 4; ++r) { zt[(4 * g + r) * 32 + fr] = a0[r]; zt[(4 * g + r) * 32 + 16 + fr] = a1[r]; }
        }
        __syncthreads();
        for (int j = 0; j < nit; ++j) { float sacc = 0.f;
#pragma unroll
            for (int w = 0; w < 8; ++w) sacc += part[(j * 8 + w) * 512 + F.tid];
            zfin[j * 512 + F.tid] = sacc; }
        __syncthreads();
        float* LG = (float*)(ws + WS_LG);
        { const int e = F.wave, dir = e >> 2, c = lane + 64 * (e & 3);
          const float* w2 = p->in[I_GW2] + ((size_t)(l * 2 + dir) * 16) * 256 + c;
          float wv[16];
#pragma unroll
          for (int r = 0; r < 16; ++r) wv[r] = w2[(size_t)r * 256];
          const float bias = p->in[I_GB][(size_t)(l * 2 + dir) * 256 + c];
          for (int j = 0; j < nit; ++j) {
            const int row0 = (F.bid + j * F.G) * 16; const LAS float* zt = zfin + j * 512;
#pragma unroll 4
            for (int rr = 0; rr < 16; ++rr) {
                const LAS f32x4* zr = (const LAS f32x4*)(zt + rr * 32 + dir * 16);
                const f32x4 z0 = zr[0], z1 = zr[1], z2 = zr[2], z3 = zr[3];
                float pre = bias;
#pragma unroll
                for (int q = 0; q < 4; ++q) pre += z0[q] * wv[q] + z1[q] * wv[4 + q] + z2[q] * wv[8 + q] + z3[q] * wv[12 + q];
                const float lsg = fminf(pre, 0.f) - __logf(1.0f + __expf(-fabsf(pre)));
                LG[((size_t)dir * MT + row0 + rr) * 256 + c] = lsg * (1.0f / 16.0f);
            } } }
        __syncthreads();
    }
}

constexpr int KV_PITCH = 144, KV_BUF = 64 * KV_PITCH;
__device__ __forceinline__ void kv_load(const bf16* P, const bf16* VT, int kcol, size_t krow0, int vkey0, int tid, u32x4& kr, u32x4& vr) {
    const int row = tid >> 3, ch = tid & 7;
    kr = *(const u32x4*)(P + (krow0 + row) * NPI + kcol + ch * 8);
    vr = *(const u32x4*)(VT + (size_t)row * KEYS + vkey0 + ch * 8);
}
__device__ __forceinline__ void kv_store(LAS unsigned char* kb, LAS unsigned char* vb, int tid, const u32x4& kr, const u32x4& vr) {
    const int row = tid >> 3, ch = tid & 7;
    *(LAS u32x4*)(kb + row * KV_PITCH + ch * 16) = kr; *(LAS u32x4*)(vb + row * KV_PITCH + ch * 16) = vr;
}
__device__ __forceinline__ bf16x8 v_frag(const LAS unsigned char* vb, int d, int ko, int fr, int g) {
    const LAS unsigned char* a = vb + (d * 16 + fr) * KV_PITCH + (ko + 4 * g) * 2;
    const u32x2 lo = *(const LAS u32x2*)a, hi = *(const LAS u32x2*)(a + 32);
    u32x4 w; w.x = lo.x; w.y = lo.y; w.z = hi.x; w.w = hi.y; return __builtin_bit_cast(bf16x8, w);
}

__device__ __forceinline__ float block_max(const float* v, int n, const Frame& F, volatile LAS float* red) {
    float mxv = 0.f;
    for (int i = F.tid; i < n; i += NTHR) mxv = fmaxf(mxv, v[i]);
#pragma unroll
    for (int o = 1; o < 64; o <<= 1) mxv = fmaxf(mxv, __shfl_xor(mxv, o));
    __syncthreads();
    if (F.lane == 0) red[F.wave] = mxv;
    __syncthreads();
    float r = red[0];
#pragma unroll
    for (int w8 = 1; w8 < 8; ++w8) r = fmaxf(r, red[w8]);
    return r;
}
__device__ __forceinline__ void diffattn_block(const bf16* P, const bf16* VTA, bf16* MIX, const Frame& F, int b, int h, int qrow_blk, int ntiles, float lam, float oscale, const float* normg, const float* kn  , int nkeys) {
    const int lane = F.lane, fr = lane & 15, g = lane >> 4, tid = F.tid;
    const int q0row = qrow_blk + 32 * F.wave;
    LAS unsigned char* lds = F.lds;
    bf16x8 qf[2][2];
#pragma unroll
    for (int m = 0; m < 2; ++m)
#pragma unroll
        for (int qt = 0; qt < 2; ++qt) qf[m][qt] = *(const bf16x8*)(P + (size_t)(q0row + qt * 16 + fr) * NPI + A_Q + h * 64 + m * 32 + 8 * g);
    volatile LAS float* red = (volatile LAS float*)(lds + MISC_OFF + 192);
    float kmax2[2];
#pragma unroll
    for (int m = 0; m < 2; ++m) kmax2[m] = block_max(kn + (size_t)(2 * h + m) * KEYS, nkeys, F, red);
    f32x4 O[2][2][4]; float mx[2][2], ls[2][2];
#pragma unroll
    for (int m = 0; m < 2; ++m)
#pragma unroll
        for (int qt = 0; qt < 2; ++qt) { ls[m][qt] = 0.f;
            float qn2 = 0.f;
#pragma unroll
            for (int j = 0; j < 8; ++j) { const float qv = bf2f((bf16)qf[m][qt][j]); qn2 += qv * qv; }
            qn2 = xsum32(xsum16(qn2));
            mx[m][qt] = sqrtf(qn2 * kmax2[m]);
#pragma unroll
            for (int d = 0; d < 4; ++d) O[m][qt][d] = (f32x4){0.f, 0.f, 0.f, 0.f}; }
    const bf16* vt = VTA + ((size_t)(b * 8 + h) * 64) * KEYS;
    const f32x4 zero = {0.f, 0.f, 0.f, 0.f};
    u32x4 kreg, vreg;
#define DA_TILE_LOAD(t) do { const int key0_ = (t) * 64; const size_t krow0_ = key0_ < CTXL ? (size_t)(NLAT + b * CTXL + key0_) : (size_t)(b * SEQ + key0_ - CTXL); \
        kv_load(P, vt, A_K + h * 64, krow0_, key0_, tid, kreg, vreg); } while (0)
    DA_TILE_LOAD(0);
    for (int t = 0; t < ntiles; ++t) {
        LAS unsigned char* kb = lds + (t & 1) * 2 * KV_BUF; LAS unsigned char* vb = kb + KV_BUF;
        kv_store(kb, vb, tid, kreg, vreg);
        __syncthreads();
        if (t + 1 < ntiles) DA_TILE_LOAD(t + 1);
#pragma unroll
        for (int st = 0; st < 2; ++st) {
            const int ko = 32 * st;
            bf16x8 kf[2][2], vf[4];
#pragma unroll
            for (int m = 0; m < 2; ++m)
#pragma unroll
                for (int kt = 0; kt < 2; ++kt) kf[m][kt] = *(const LAS bf16x8*)(kb + (ko + kt * 16 + fr) * KV_PITCH + (m * 32 + 8 * g) * 2);
#pragma unroll
            for (int d = 0; d < 4; ++d) vf[d] = v_frag(vb, d, ko, fr, g);
            bf16x8 pb[2][2];
#pragma unroll
            for (int m = 0; m < 2; ++m) {
                f32x4 sc[2][2];
#pragma unroll
                for (int qt = 0; qt < 2; ++qt) { const float nb = -mx[m][qt]; const f32x4 c0 = {nb, nb, nb, nb};
#pragma unroll
                    for (int kt = 0; kt < 2; ++kt) sc[qt][kt] = __builtin_amdgcn_mfma_f32_16x16x32_bf16(kf[m][kt], qf[m][qt], c0, 0, 0, 0); }
                __builtin_amdgcn_sched_barrier(0);
#pragma unroll
                for (int qt = 0; qt < 2; ++qt) {
                    const f32x4 s0 = sc[qt][0], s1 = sc[qt][1];
                    const float p0 = fexp2(s0[0]), p1 = fexp2(s0[1]), p2 = fexp2(s0[2]), p3 = fexp2(s0[3]);
                    const float p4 = fexp2(s1[0]), p5 = fexp2(s1[1]), p6 = fexp2(s1[2]), p7 = fexp2(s1[3]);
                    ls[m][qt] += ((p0 + p1) + (p2 + p3)) + ((p4 + p5) + (p6 + p7));
                    u32x4 pw; pw.x = cvt_pk_bf16(p0, p1); pw.y = cvt_pk_bf16(p2, p3); pw.z = cvt_pk_bf16(p4, p5); pw.w = cvt_pk_bf16(p6, p7);
                    pb[m][qt] = __builtin_bit_cast(bf16x8, pw);
                }
                __builtin_amdgcn_sched_barrier(0);
            }
#pragma unroll
            for (int m = 0; m < 2; ++m)
#pragma unroll
                for (int qt = 0; qt < 2; ++qt)
#pragma unroll
                    for (int d = 0; d < 4; ++d) O[m][qt][d] = __builtin_amdgcn_mfma_f32_16x16x32_bf16(vf[d], pb[m][qt], O[m][qt][d], 0, 0, 0);
            __builtin_amdgcn_sched_barrier(0);
        }
    }
#undef DA_TILE_LOAD
#pragma unroll
    for (int qt = 0; qt < 2; ++qt) {
        const float l0 = xsum32(xsum16(ls[0][qt]));
        const float l1 = xsum32(xsum16(ls[1][qt]));
        const float i0 = 1.0f / l0, i1 = lam / l1;
        f32x4 o[4]; float ss = 0.f;
#pragma unroll
        for (int d = 0; d < 4; ++d) { o[d] = O[0][qt][d] * i0 - O[1][qt][d] * i1; ss += (o[d][0] * o[d][0] + o[d][1] * o[d][1]) + (o[d][2] * o[d][2] + o[d][3] * o[d][3]); }
        ss = xsum32(xsum16(ss));
        const float rs = oscale / sqrtf(ss * (1.0f / 64.0f) + NORM_EPS);
        bf16* op = MIX + (size_t)(q0row + qt * 16 + fr) * D + h * 64 + 4 * g;
#pragma unroll
        for (int d = 0; d < 4; ++d) { const f32x4 gn = *(const f32x4*)(normg + d * 16 + 4 * g); const f32x4 r = o[d] * rs * gn;
            u32x2 w; w.x = cvt_pk_bf16(r[0], r[1]); w.y = cvt_pk_bf16(r[2], r[3]); *(u32x2*)(op + d * 16) = w; }
    }
    __syncthreads();
}

template <bool IS_CTX>
__device__ __forceinline__ void na_block(const bf16* P, const bf16* VTB, bf16* MIX, const float* relb, const Frame& F, int b, int h, int blk, const float* kn  ) {
    const int lane = F.lane, fr = lane & 15, g = lane >> 4, tid = F.tid, w = F.wave;
    LAS unsigned char* lds = F.lds;
    const int r = IS_CTX ? 0 : 2 * blk + (w >> 2), qt = w & 3;
    const int cq = IS_CTX ? (blk * 128 + 16 * w + fr) : (16 * qt + fr);
    const int qrow = IS_CTX ? (NLAT + b * CTXL + cq) : (b * SEQ + r * 64 + cq);
    const float SC = 0.125f * LOG2E;
    bf16x8 qf[2];
#pragma unroll
    for (int ks = 0; ks < 2; ++ks) { const u32x4 qw = *(const u32x4*)(P + (size_t)qrow * NPI + B_Q + h * 64 + ks * 32 + 8 * g);
        u32x4 o; o.x = cvt_pk_bf16(bflo(qw.x) * SC, bfhi(qw.x) * SC); o.y = cvt_pk_bf16(bflo(qw.y) * SC, bfhi(qw.y) * SC); o.z = cvt_pk_bf16(bflo(qw.z) * SC, bfhi(qw.z) * SC); o.w = cvt_pk_bf16(bflo(qw.w) * SC, bfhi(qw.w) * SC);
        qf[ks] = __builtin_bit_cast(bf16x8, o); }
    LAS float* biasl = (LAS float*)(lds + 4 * KV_BUF);
    if (!IS_CTX) { if (tid < 15 * 31) biasl[tid] = relb[h * 465 + tid] * LOG2E; }
    const int wlo = qt == 0 ? 0 : (qt == 1 ? 8 : (qt == 2 ? 24 : 32));
    const int rs = min(max(r - 4, 0), 24), cs = min(max(cq - 8, 0), 48);
    const int klo = IS_CTX ? 0 : min(max(2 * blk - 4, 0), 24), khi = IS_CTX ? -1 : (min(max(2 * blk + 1 - 4, 0), 24) + 7);
    const int nlat = khi - klo + 1, ntiles = nlat + 4;
    f32x4 O[4]; float ls = 0.f;
#pragma unroll
    for (int d = 0; d < 4; ++d) O[d] = (f32x4){0.f, 0.f, 0.f, 0.f};
    const bf16* vt = VTB + ((size_t)(b * 8 + h) * 64) * KEYS;
    float mx;
    { float qn2 = 0.f;
#pragma unroll
      for (int ks = 0; ks < 2; ++ks)
#pragma unroll
          for (int j = 0; j < 8; ++j) { const float qv = bf2f((bf16)qf[ks][j]); qn2 += qv * qv; }
      qn2 = xsum32(xsum16(qn2));
      float bm = 0.f;
      if (!IS_CTX) { for (int i2 = lane; i2 < 15 * 31; i2 += 64) bm = fmaxf(bm, relb[h * 465 + i2]);
#pragma unroll
          for (int o = 1; o < 64; o <<= 1) bm = fmaxf(bm, __shfl_xor(bm, o)); }
      const float kmax2 = block_max(kn, IS_CTX ? CTXL : KEYS, F, (volatile LAS float*)(lds + MISC_OFF + 192));
      mx = sqrtf(qn2 * kmax2) + bm * LOG2E; }
    const f32x4 cinit = {-mx, -mx, -mx, -mx};
    const f32x4 zero = {0.f, 0.f, 0.f, 0.f};
    u32x4 kreg, vreg;
#define NA_TILE_LOAD(t) do { const bool lat_ = (t) < nlat; const int kr_ = klo + (t), j0_ = ((t) - nlat) * 64; \
        kv_load(P, vt, B_K + h * 64, lat_ ? (size_t)(b * SEQ + kr_ * 64) : (size_t)(NLAT + b * CTXL + j0_), lat_ ? (CTXL + kr_ * 64) : j0_, tid, kreg, vreg); } while (0)
    NA_TILE_LOAD(0);
    for (int t = 0; t < ntiles; ++t) {
        LAS unsigned char* kb = lds + (t & 1) * 2 * KV_BUF; LAS unsigned char* vb = kb + KV_BUF;
        kv_store(kb, vb, tid, kreg, vreg);
        __syncthreads();
        if (t + 1 < ntiles) NA_TILE_LOAD(t + 1);
        const bool lat = t < nlat;
        const int kr = klo + t;
        if (lat && (kr < rs || kr > rs + 7)) continue;
        const int nst = lat ? 1 : 2;
        for (int st = 0; st < nst; ++st) {
            const int ko = lat ? wlo : 32 * st;
            bf16x8 kf[2][2], vf[4];
#pragma unroll
            for (int kt = 0; kt < 2; ++kt)
#pragma unroll
                for (int ks = 0; ks < 2; ++ks) kf[kt][ks] = *(const LAS bf16x8*)(kb + (ko + kt * 16 + fr) * KV_PITCH + (ks * 32 + 8 * g) * 2);
#pragma unroll
            for (int d = 0; d < 4; ++d) vf[d] = v_frag(vb, d, ko, fr, g);
            f32x4 s[2];
#pragma unroll
            for (int kt = 0; kt < 2; ++kt) { s[kt] = __builtin_amdgcn_mfma_f32_16x16x32_bf16(kf[kt][0], qf[0], cinit, 0, 0, 0); s[kt] = __builtin_amdgcn_mfma_f32_16x16x32_bf16(kf[kt][1], qf[1], s[kt], 0, 0, 0); }
            float v[8];
#pragma unroll
            for (int kt = 0; kt < 2; ++kt)
#pragma unroll
                for (int rr = 0; rr < 4; ++rr) {
                    float x = s[kt][rr];
                    if (lat) { const int ck = wlo + kt * 16 + 4 * g + rr; const bool ok = (ck >= cs) && (ck < cs + 16);
                        const int dr = kr - r + 7, dc = min(max(ck - cq + 15, 0), 30);
                        x = ok ? (x + biasl[dr * 31 + dc]) : -__builtin_inff(); }
                    v[kt * 4 + rr] = x;
                }
            float pp[8];
#pragma unroll
            for (int i = 0; i < 8; ++i) pp[i] = fexp2(v[i]);
            ls += ((pp[0] + pp[1]) + (pp[2] + pp[3])) + ((pp[4] + pp[5]) + (pp[6] + pp[7]));
            u32x4 pw; pw.x = cvt_pk_bf16(pp[0], pp[1]); pw.y = cvt_pk_bf16(pp[2], pp[3]); pw.z = cvt_pk_bf16(pp[4], pp[5]); pw.w = cvt_pk_bf16(pp[6], pp[7]);
            const bf16x8 pb = __builtin_bit_cast(bf16x8, pw);
#pragma unroll
            for (int d = 0; d < 4; ++d) O[d] = __builtin_amdgcn_mfma_f32_16x16x32_bf16(vf[d], pb, O[d], 0, 0, 0);
        }
    }
#undef NA_TILE_LOAD
    const float lt = xsum32(xsum16(ls));
    const float il = 1.0f / lt;
    bf16* op = MIX + (size_t)qrow * D + 512 + h * 64 + 4 * g;
#pragma unroll
    for (int d = 0; d < 4; ++d) { const f32x4 rr = O[d] * il; u32x2 w2; w2.x = cvt_pk_bf16(rr[0], rr[1]); w2.y = cvt_pk_bf16(rr[2], rr[3]); *(u32x2*)(op + d * 16) = w2; }
    __syncthreads();
}

__device__ __forceinline__ int pos_row(int pos, int b, int dir) {
    if (pos < CTXL) { const int j = dir ? (CTXL - 1 - pos) : pos; return NLAT + b * CTXL + j; }
    const int t = pos - CTXL; return b * SEQ + (dir ? (SEQ - 1 - t) : t);
}
template <bool HG>
__device__ __forceinline__ void cd_chunk_seq(KP p, const Frame& F, int l, bool ctx_out, int b, int h, int dir, int colhalf) {
    constexpr int DK = HG ? 128 : 64, DVL = HG ? 64 : 128, C = 64, NCH = KEYS / C;
    constexpr int PK = DK * 2 + 16, PC = 144;
    constexpr int CPT = DK / 64;
    constexpr int VPT = DVL / 64;
    constexpr int KS = DK / 32;
    constexpr int NVT = DVL / 32;
    constexpr int O_QT = 0, O_KT = O_QT + 64 * PK, O_QE = O_KT + 64 * PK, O_KD = O_QE + 64 * PK, O_VT = O_KD + DK * PC, O_PM = O_VT + DVL * PC,
                  O_ST = O_PM + 64 * PC, ST_BYTES = DVL * PK, O_SEG = O_ST + 2 * ST_BYTES, O_DEC = O_SEG + 8 * DK * 4, O_END = O_DEC + DK * 4;
    static_assert(O_END <= RING_BYTES, "cd lds");
    unsigned char* ws = p->ws;
    const bf16* P = (const bf16*)(ws + WS_P);
    const float* LA = HG ? (const float*)(ws + WS_HLA) + (size_t)dir * MT * 512 + h * 128 : (const float*)(ws + WS_LG) + (size_t)dir * MT * 256 + h * 64;
    constexpr int LAW = HG ? 512 : 256;
    float* OUT = (float*)(ws + (HG ? WS_OC : WS_OD)) + (size_t)dir * MT * 512;
    LAS unsigned char* lds = F.lds;
    const int lane = F.lane, w = F.wave, fr = lane & 15, g = lane >> 4;
    const int d0 = CPT * lane;
    const int colbase = HG ? colhalf * 64 : 0;
    const int qcol = HG ? (C_Q + h * 128 + d0) : (D_Q + h * 64 + d0);
    const int kcol = HG ? ((dir ? C_FB : C_FF) + h * 128 + d0) : (D_K + h * 64 + d0);
    const int vcol = (HG ? C_I : D_V) + h * 128 + colbase + VPT * lane;
    const float qscale = HG ? 1.0f : 0.125f;
    const int sdt = HG ? w : (w >> 1), svt0 = HG ? 0 : 4 * (w & 1);
    f32x4 Sacc[4];
#pragma unroll
    for (int t = 0; t < 4; ++t) Sacc[t] = (f32x4){0.f, 0.f, 0.f, 0.f};
    for (int i = F.tid; i < ST_BYTES / 4; i += NTHR) ((LAS unsigned*)(lds + O_ST + ST_BYTES))[i] = 0u;
    unsigned qr[8], kr[8], vr[8]; float lr[8][CPT];
#define CD_PREFETCH(cn) do { \
        _Pragma("unroll") for (int ii = 0; ii < 8; ++ii) { const size_t row = (size_t)pos_row((cn) * C + 8 * w + ii, b, dir); const bf16* pr = P + row * NPI; \
            if (CPT == 2) { qr[ii] = *(const unsigned*)(pr + qcol); kr[ii] = *(const unsigned*)(pr + kcol); const f32x2 t2 = *(const f32x2*)(LA + row * LAW + d0); lr[ii][0] = t2[0]; lr[ii][CPT - 1] = t2[1]; } \
            else { qr[ii] = pr[qcol]; kr[ii] = pr[kcol]; lr[ii][0] = LA[row * LAW + d0]; } \
            if (VPT == 2) vr[ii] = *(const unsigned*)(pr + vcol); else vr[ii] = pr[vcol]; } } while (0)
    CD_PREFETCH(0);
    __syncthreads();
    for (int c = 0; c < NCH; ++c) {
        float la[8][CPT], qq[8][CPT], kk[8][CPT]; unsigned vv[VPT][4];
        float run[CPT];
#pragma unroll
        for (int u = 0; u < CPT; ++u) run[u] = 0.f;
#pragma unroll
        for (int ii = 0; ii < 8; ++ii) {
            if (CPT == 2) { qq[ii][0] = bflo(qr[ii]); qq[ii][CPT - 1] = bfhi(qr[ii]); kk[ii][0] = bflo(kr[ii]); kk[ii][CPT - 1] = bfhi(kr[ii]); }
            else { qq[ii][0] = bflo(qr[ii]) * qscale; kk[ii][0] = bflo(kr[ii]); }
#pragma unroll
            for (int u = 0; u < CPT; ++u) { run[u] += lr[ii][u]; la[ii][u] = run[u]; }
        }
        if (VPT == 2) {
#pragma unroll
            for (int q4 = 0; q4 < 4; ++q4) { vv[0][q4] = (vr[2 * q4] & 0xffffu) | (vr[2 * q4 + 1] << 16); vv[VPT - 1][q4] = (vr[2 * q4] >> 16) | (vr[2 * q4 + 1] & 0xffff0000u); }
        } else {
#pragma unroll
            for (int q4 = 0; q4 < 4; ++q4) vv[0][q4] = (vr[2 * q4] & 0xffffu) | (vr[2 * q4 + 1] << 16);
        }
#pragma unroll
        for (int u = 0; u < CPT; ++u) ((LAS float*)(lds + O_SEG))[w * DK + d0 + u] = run[u];
        if (c + 1 < NCH) CD_PREFETCH(c + 1);
        __syncthreads();
        float off[CPT], rv[CPT], bend[CPT];
#pragma unroll
        for (int u = 0; u < CPT; ++u) { off[u] = 0.f; rv[u] = 0.f; bend[u] = 0.f; }
#pragma unroll
        for (int s2 = 0; s2 < 8; ++s2)
#pragma unroll
            for (int u = 0; u < CPT; ++u) { const float t = ((LAS float*)(lds + O_SEG))[s2 * DK + d0 + u]; off[u] += (s2 < w) ? t : 0.f; rv[u] += (s2 < 4) ? t : 0.f; bend[u] += t; }
        float erv[CPT], ebr[CPT];
#pragma unroll
        for (int u = 0; u < CPT; ++u) { erv[u] = __expf(rv[u]); ebr[u] = __expf(bend[u] - rv[u]); }
        float kdv[8][CPT];
#pragma unroll
        for (int ii = 0; ii < 8; ++ii) {
            float qt[CPT], kt[CPT], qe[CPT];
#pragma unroll
            for (int u = 0; u < CPT; ++u) { const float bi = off[u] + la[ii][u];
                const float x1 = __expf(fminf(fmaxf(bi - rv[u], -60.0f), 60.0f));
                qt[u] = qq[ii][u] * x1; kt[u] = kk[ii][u] * __builtin_amdgcn_rcpf(x1); qe[u] = qt[u] * erv[u]; kdv[ii][u] = kt[u] * ebr[u]; }
            const int i = 8 * w + ii;
            if (CPT == 2) {
                *(LAS unsigned*)(lds + O_QT + i * PK + d0 * 2) = cvt_pk_bf16(qt[0], qt[CPT - 1]);
                *(LAS unsigned*)(lds + O_KT + i * PK + d0 * 2) = cvt_pk_bf16(kt[0], kt[CPT - 1]);
                *(LAS unsigned*)(lds + O_QE + i * PK + d0 * 2) = cvt_pk_bf16(qe[0], qe[CPT - 1]);
            } else {
                *(LAS bf16*)(lds + O_QT + i * PK + d0 * 2) = (bf16)(cvt_pk_bf16(qt[0], 0.f) & 0xffffu);
                *(LAS bf16*)(lds + O_KT + i * PK + d0 * 2) = (bf16)(cvt_pk_bf16(kt[0], 0.f) & 0xffffu);
                *(LAS bf16*)(lds + O_QE + i * PK + d0 * 2) = (bf16)(cvt_pk_bf16(qe[0], 0.f) & 0xffffu);
            }
        }
#pragma unroll
        for (int u = 0; u < CPT; ++u) { u32x4 wv4; wv4.x = cvt_pk_bf16(kdv[0][u], kdv[1][u]); wv4.y = cvt_pk_bf16(kdv[2][u], kdv[3][u]); wv4.z = cvt_pk_bf16(kdv[4][u], kdv[5][u]); wv4.w = cvt_pk_bf16(kdv[6][u], kdv[7][u]);
            *(LAS u32x4*)(lds + O_KD + (d0 + u) * PC + (8 * w) * 2) = wv4; }
#pragma unroll
        for (int u = 0; u < VPT; ++u) { u32x4 wv4; wv4.x = vv[u][0]; wv4.y = vv[u][1]; wv4.z = vv[u][2]; wv4.w = vv[u][3];
            *(LAS u32x4*)(lds + O_VT + (VPT * lane + u) * PC + (8 * w) * 2) = wv4; }
        if (w == 0) {
#pragma unroll
            for (int u = 0; u < CPT; ++u) ((LAS float*)(lds + O_DEC))[d0 + u] = __expf(bend[u]);
        }
        __syncthreads();
        const LAS unsigned char* st_rd = lds + O_ST + ((c + 1) & 1) * ST_BYTES;
        LAS unsigned char* st_wr = lds + O_ST + (c & 1) * ST_BYTES;
        const bool want_out = ctx_out || c >= CTXL / C;
        if (want_out) {
            { const int it = w >> 1, jt0 = 2 * (w & 1);
              bf16x8 bq[KS], ak[2][KS];
#pragma unroll
              for (int ks = 0; ks < KS; ++ks) bq[ks] = *(const LAS bf16x8*)(lds + O_QT + (16 * it + fr) * PK + (ks * 32 + 8 * g) * 2);
#pragma unroll
              for (int t = 0; t < 2; ++t)
#pragma unroll
                  for (int ks = 0; ks < KS; ++ks) ak[t][ks] = *(const LAS bf16x8*)(lds + O_KT + (16 * (jt0 + t) + fr) * PK + (ks * 32 + 8 * g) * 2);
              __builtin_amdgcn_sched_barrier(0);
#pragma unroll
              for (int t = 0; t < 2; ++t) { const int jt = jt0 + t; f32x4 sacc = {0.f, 0.f, 0.f, 0.f};
#pragma unroll
                  for (int ks = 0; ks < KS; ++ks) sacc = __builtin_amdgcn_mfma_f32_16x16x32_bf16(ak[t][ks], bq[ks], sacc, 0, 0, 0);
                  const int i = 16 * it + fr, j0 = 16 * jt + 4 * g;
                  const float m0 = (j0 + 0 <= i) ? sacc[0] : 0.f, m1 = (j0 + 1 <= i) ? sacc[1] : 0.f, m2 = (j0 + 2 <= i) ? sacc[2] : 0.f, m3 = (j0 + 3 <= i) ? sacc[3] : 0.f;
                  u32x2 pw; pw.x = cvt_pk_bf16(m0, m1); pw.y = cvt_pk_bf16(m2, m3);
                  *(LAS u32x2*)(lds + O_PM + i * PC + j0 * 2) = pw; }
            }
            __syncthreads();
            { const int it = w >> 1;
              bf16x8 ap[2], aq[KS], bv[NVT][2], bs[NVT][KS];
#pragma unroll
              for (int ks = 0; ks < 2; ++ks) ap[ks] = *(const LAS bf16x8*)(lds + O_PM + (16 * it + fr) * PC + (ks * 32 + 8 * g) * 2);
#pragma unroll
              for (int ks = 0; ks < KS; ++ks) aq[ks] = *(const LAS bf16x8*)(lds + O_QE + (16 * it + fr) * PK + (ks * 32 + 8 * g) * 2);
#pragma unroll
              for (int t = 0; t < NVT; ++t) { const int vt = (w & 1) * NVT + t;
#pragma unroll
                  for (int ks = 0; ks < 2; ++ks) bv[t][ks] = *(const LAS bf16x8*)(lds + O_VT + (16 * vt + fr) * PC + (ks * 32 + 8 * g) * 2);
#pragma unroll
                  for (int ks = 0; ks < KS; ++ks) bs[t][ks] = *(const LAS bf16x8*)(st_rd + (16 * vt + fr) * PK + (ks * 32 + 8 * g) * 2); }
              __builtin_amdgcn_sched_barrier(0);
              f32x4 oacc[NVT];
#pragma unroll
              for (int t = 0; t < NVT; ++t) { oacc[t] = (f32x4){0.f, 0.f, 0.f, 0.f};
#pragma unroll
                  for (int ks = 0; ks < 2; ++ks) oacc[t] = __builtin_amdgcn_mfma_f32_16x16x32_bf16(ap[ks], bv[t][ks], oacc[t], 0, 0, 0);
#pragma unroll
                  for (int ks = 0; ks < KS; ++ks) oacc[t] = __builtin_amdgcn_mfma_f32_16x16x32_bf16(aq[ks], bs[t][ks], oacc[t], 0, 0, 0); }
              float* orow[4];
#pragma unroll
              for (int r = 0; r < 4; ++r) orow[r] = OUT + (size_t)pos_row(c * C + 16 * it + 4 * g + r, b, dir) * 512 + h * 128 + colbase + (w & 1) * NVT * 16 + fr;
#pragma unroll
              for (int t = 0; t < NVT; ++t)
#pragma unroll
                  for (int r = 0; r < 4; ++r) orow[r][16 * t] = oacc[t][r];
            }
        }
        { bf16x8 ak[2], bv[4][2];
#pragma unroll
          for (int ks = 0; ks < 2; ++ks) ak[ks] = *(const LAS bf16x8*)(lds + O_KD + (16 * sdt + fr) * PC + (ks * 32 + 8 * g) * 2);
          const f32x4 dec4 = *(const LAS f32x4*)(lds + O_DEC + (16 * sdt + 4 * g) * 4);
#pragma unroll
          for (int t = 0; t < 4; ++t)
#pragma unroll
              for (int ks = 0; ks < 2; ++ks) bv[t][ks] = *(const LAS bf16x8*)(lds + O_VT + (16 * (svt0 + t) + fr) * PC + (ks * 32 + 8 * g) * 2);
          __builtin_amdgcn_sched_barrier(0);
#pragma unroll
          for (int t = 0; t < 4; ++t) { const int vt = svt0 + t; Sacc[t] = Sacc[t] * dec4;
#pragma unroll
              for (int ks = 0; ks < 2; ++ks) Sacc[t] = __builtin_amdgcn_mfma_f32_16x16x32_bf16(ak[ks], bv[t][ks], Sacc[t], 0, 0, 0);
              u32x2 sw; sw.x = cvt_pk_bf16(Sacc[t][0], Sacc[t][1]); sw.y = cvt_pk_bf16(Sacc[t][2], Sacc[t][3]);
              *(LAS u32x2*)(st_wr + (16 * vt + fr) * PK + (16 * sdt + 4 * g) * 2) = sw; }
        }
    }
#undef CD_PREFETCH
    __syncthreads();
}

__device__ __forceinline__ void cd_combine_phase(KP p, const Frame& F, int l, bool ctx_out) {
    unsigned char* ws = p->ws;
    const bf16* P = (const bf16*)(ws + WS_P); bf16* MIX = (bf16*)(ws + WS_MIX);
    const int gw = F.bid * NWAVES + F.wave, NGW = F.G * NWAVES, lane = F.lane;
    const int nrows = ctx_out ? MT : NLAT;
    for (int it = gw; it < 2 * nrows; it += NGW) {
        const int mix = it / nrows, m = it % nrows;
        const float* o0 = (const float*)(ws + (mix ? WS_OD : WS_OC)) + (size_t)m * 512 + 8 * lane; const float* o1 = o0 + (size_t)MT * 512;
        const f32x4 a0 = *(const f32x4*)o0 + *(const f32x4*)o1, a1 = *(const f32x4*)(o0 + 4) + *(const f32x4*)(o1 + 4);
        float ss = (a0[0] * a0[0] + a0[1] * a0[1]) + (a0[2] * a0[2] + a0[3] * a0[3]) + (a1[0] * a1[0] + a1[1] * a1[1]) + (a1[2] * a1[2] + a1[3] * a1[3]);
        ss += __shfl_xor(ss, 1); ss += __shfl_xor(ss, 2); ss += __shfl_xor(ss, 4); ss += __shfl_xor(ss, 8);
        const float rstd = 1.0f / sqrtf(ss * (1.0f / 128.0f) + NORM_EPS);
        const float* ng = p->in[mix ? I_GNORM : I_HNORM] + (size_t)l * 128 + ((8 * lane) & 127);
        const f32x4 g0 = *(const f32x4*)ng, g1 = *(const f32x4*)(ng + 4);
        const u32x4 gw4 = *(const u32x4*)(P + (size_t)m * NPI + (mix ? D_R : C_G) + 8 * lane);
        float gt[8] = {bflo(gw4.x), bfhi(gw4.x), bflo(gw4.y), bfhi(gw4.y), bflo(gw4.z), bfhi(gw4.z), bflo(gw4.w), bfhi(gw4.w)};
        float r[8];
#pragma unroll
        for (int j = 0; j < 4; ++j) { r[j] = a0[j] * rstd * g0[j] * fsilu(gt[j]); r[4 + j] = a1[j] * rstd * g1[j] * fsilu(gt[4 + j]); }
        u32x4 w; w.x = cvt_pk_bf16(r[0], r[1]); w.y = cvt_pk_bf16(r[2], r[3]); w.z = cvt_pk_bf16(r[4], r[5]); w.w = cvt_pk_bf16(r[6], r[7]);
        *(u32x4*)(MIX + (size_t)m * D + (mix ? 1536 : 1024) + 8 * lane) = w;
    }
}

constexpr int CD_BLOCKS = 96;
__device__ __forceinline__ void cd_item(KP p, const Frame& F, int l, bool ctx_out, int it) {
    if (it < 64) { const int colhalf = it & 1, dir = (it >> 1) & 1, h = (it >> 2) & 3, b = it >> 4; cd_chunk_seq<true>(p, F, l, ctx_out, b, h, dir, colhalf); }
    else { const int i = it - 64, dir = i & 1, h = (i >> 1) & 3, b = i >> 3; cd_chunk_seq<false>(p, F, l, ctx_out, b, h, dir, 0); }
}
__device__ __forceinline__ void mixer_phase(KP p, const Frame& F, int l, bool ctx_out) {
    unsigned char* ws = p->ws;
    if (F.G >= 256) { if (F.bid < CD_BLOCKS) { cd_item(p, F, l, ctx_out, F.bid); if ((PROBE_DUP) == 31) cd_item(p, F, l, ctx_out, F.bid); } }
    else { for (int it = F.bid; it < CD_BLOCKS; it += F.G) cd_item(p, F, l, ctx_out, it); }
    const bf16* P = (const bf16*)(ws + WS_P); bf16* MIX = (bf16*)(ws + WS_MIX);
    const int x = F.bid & 7;
    unsigned* qhead = (unsigned*)(ws + WS_CTL) + CW_QUEUE + 64 * (8 * l + x);
    volatile LAS unsigned* slot = (volatile LAS unsigned*)(F.lds + MISC_OFF + 64);
    const float* lp = p->in[I_DLAM] + (size_t)l * 128;
    float s01 = 0.f, s23 = 0.f;
    for (int i = 0; i < 32; ++i) { s01 += lp[i] * lp[32 + i]; s23 += lp[64 + i] * lp[96 + i]; }
    const float li = 0.8f - 0.6f * expf(-0.3f * (float)l);
    const float lam = expf(s01) - expf(s23) + li;
    const bf16* VTA = (const bf16*)(ws + WS_VTA); const bf16* VTB = (const bf16*)(ws + WS_VTB);
    const float* ng = p->in[I_DNORM] + (size_t)l * 64;
    const float* relb = p->in[I_RELB] + (size_t)l * 8 * 15 * 31;
    const float* kna = (const float*)(ws + WS_KNA); const float* knb = (const float*)(ws + WS_KNB);
    const int perA = 8 + (ctx_out ? 1 : 0), perB = 16 + (ctx_out ? 2 : 0), nA = 4 * perA, nTot = nA + 4 * perB;
    const int nExtra = ((PROBE_DUP) == 32) ? nTot : ((PROBE_DUP) == 33) ? nA : ((PROBE_DUP) == 34) ? (nTot - nA) : 0;
    for (;;) {
        __syncthreads();
        if (F.tid == 0) *slot = atomicAdd(qhead, 1u);
        __syncthreads();
        int it = (int)*slot;
        if (it >= nTot + nExtra) break;
        if (it >= nTot) it = it - nTot + (((PROBE_DUP) == 34) ? nA : 0);
        if (it < nA) {
            const int bh = x + 8 * (it / perA), j = it % perA, b = bh >> 3, h = bh & 7;
            if (j < 8) diffattn_block(P, VTA, MIX, F, b, h, b * SEQ + j * 256, KEYS / 64, lam, 1.0f - li, ng, kna + (size_t)b * 16 * KEYS, KEYS);
            else diffattn_block(P, VTA, MIX, F, b, h, NLAT + b * CTXL, CTXL / 64, lam, 1.0f - li, ng, kna + (size_t)b * 16 * KEYS, CTXL);
        } else {
            const int i2 = it - nA, bh = x + 8 * (i2 / perB), j = i2 % perB, b = bh >> 3, h = bh & 7;
            if (j < 16) na_block<false>(P, VTB, MIX, relb, F, b, h, j, knb + ((size_t)b * 8 + h) * KEYS);
            else na_block<true>(P, VTB, MIX, relb, F, b, h, j - 16, knb + ((size_t)b * 8 + h) * KEYS);
        }
    }
}

__device__ __forceinline__ void moe_gather_phase(KP p, const Frame& F) {
    unsigned char* ws = p->ws;
    unsigned* ctl = (unsigned*)(ws + WS_CTL);
    volatile LAS int* gtot = (volatile LAS int*)(F.lds + MISC_OFF + 512);
    { const unsigned* bc = (const unsigned*)(ws + WS_BCNT); const int e = F.wave, j = F.lane;
      int v4[4]; int part = 0, mine_before = 0;
#pragma unroll
      for (int q = 0; q < 4; ++q) { const int b2 = 4 * j + q; v4[q] = b2 < F.G ? (int)bc[(size_t)b2 * 8 + e] : 0; part += v4[q]; if (b2 < F.bid) mine_before += v4[q]; }
      int incl = part;
#pragma unroll
      for (int o = 1; o < 64; o <<= 1) { const int t = __shfl_up(incl, o); if (j >= o) incl += t; }
      const int total = __shfl(incl, 63);
      const int excl = incl - part;
      const int jb = F.bid >> 2;
      const int base_e = __shfl(excl, jb) + __shfl(mine_before, jb);
      if (j == 0) { gtot[e] = total; gtot[8 + e] = base_e; gtot[16 + e] = 0; }
    }
    __syncthreads();
    int off[8], bse[8]; int tot = 0;
#pragma unroll
    for (int e = 0; e < 8; ++e) { const int c = gtot[e]; off[e] = tot; bse[e] = tot + gtot[8 + e]; tot += ((c + 255) >> 8) << 8; }
    if (F.bid == 0 && F.tid == 0) {
        ctl[CW_PANEL] = (unsigned)(tot >> 8);
#pragma unroll
        for (int e = 0; e < 8; ++e) { const int pe = (e == 7 ? tot : off[e + 1]) >> 8; for (int q = off[e] >> 8; q < pe; ++q) ctl[CW_PANEL + 1 + q] = (unsigned)e; }
    }
    const bf16* H = (const bf16*)(ws + WS_H); bf16* HS = (bf16*)(ws + WS_HS);
    const unsigned* RT = (const unsigned*)(ws + WS_ROUTE); int* POS = (int*)(ws + WS_POS);
    const int gw = F.bid * NWAVES + F.wave, NGW = F.G * NWAVES;
    for (int m = gw; m < NLAT; m += NGW) {
        const int i0 = (int)RT[(size_t)m * 4], i1 = (int)RT[(size_t)m * 4 + 1];
        int p0 = 0, p1 = 0;
        if (F.lane == 0) { p0 = (int)__hip_atomic_fetch_add((LAS int*)(gtot + 16 + i0), 1, __ATOMIC_RELAXED, __HIP_MEMORY_SCOPE_WORKGROUP); p1 = (int)__hip_atomic_fetch_add((LAS int*)(gtot + 16 + i1), 1, __ATOMIC_RELAXED, __HIP_MEMORY_SCOPE_WORKGROUP); }
        p0 = __shfl(p0, 0); p1 = __shfl(p1, 0);
        int o0 = 0, o1 = 0;
#pragma unroll
        for (int e = 0; e < 8; ++e) { o0 = (e == i0) ? bse[e] : o0; o1 = (e == i1) ? bse[e] : o1; }
        p0 += o0; p1 += o1;
        if (F.lane == 0) { POS[(size_t)m * 2] = p0; POS[(size_t)m * 2 + 1] = p1; }
        const u32x4* src = (const u32x4*)((const unsigned char*)H + (size_t)m * D) + F.lane;
        u32x4* d0 = (u32x4*)((unsigned char*)HS + (size_t)p0 * D) + F.lane; u32x4* d1 = (u32x4*)((unsigned char*)HS + (size_t)p1 * D) + F.lane;
        { const u32x4 va = src[0], vb = src[64]; d0[0] = va; d0[64] = vb; d1[0] = va; d1[64] = vb; }
    }
    __syncthreads();
}

__device__ __forceinline__ void final_phase(KP p, const Frame& F) {
    unsigned char* ws = p->ws;
    const float* X = (const float*)(ws + WS_X); const bf16* Y = (const bf16*)(ws + WS_Y);
    const float* MOD = (const float*)(ws + WS_MOD) + (size_t)1 * 5 * MODW;
    const unsigned* RT = (const unsigned*)(ws + WS_ROUTE); const int* POS = (const int*)(ws + WS_POS);
    const int gw = F.bid * NWAVES + F.wave, NGW = F.G * NWAVES;
    for (int m = gw; m < NLAT; m += NGW) {
        const int b = m >> 11;
        const float w0 = __uint_as_float(RT[(size_t)m * 4 + 2]), w1 = __uint_as_float(RT[(size_t)m * 4 + 3]);
        const int p0 = POS[(size_t)m * 2], p1 = POS[(size_t)m * 2 + 1];
        const f32x4* xr = (const f32x4*)(X + (size_t)m * D) + F.lane; const u32x2* y0 = (const u32x2*)(Y + (size_t)p0 * D) + F.lane; const u32x2* y1 = (const u32x2*)(Y + (size_t)p1 * D) + F.lane;
        const f32x4* gp = (const f32x4*)(MOD + (size_t)b * MODW + 5 * D) + F.lane;
        const int split0 = MOE_FULL_PANELS * 256;
        const f32x4* q0 = (const f32x4*)((const float*)(ws + WS_SPLIT) + (size_t)(p0 - split0) * D) + F.lane; const f32x4* q1 = (const f32x4*)((const float*)(ws + WS_SPLIT) + (size_t)(p1 - split0) * D) + F.lane;
        f32x4 v[8]; float ss = 0.f;
#pragma unroll
        for (int j = 0; j < 8; ++j) {
            f32x4 a0, a1;
            if (p0 < split0) { const u32x2 w = y0[64 * j]; a0 = (f32x4){bflo(w.x), bfhi(w.x), bflo(w.y), bfhi(w.y)}; } else { a0 = q0[64 * j];
#pragma unroll
                for (int ks = 1; ks < MOE_KS; ++ks) a0 = a0 + q0[(size_t)ks * 8 * 256 * D / 4 + 64 * j]; }
            if (p1 < split0) { const u32x2 w = y1[64 * j]; a1 = (f32x4){bflo(w.x), bfhi(w.x), bflo(w.y), bfhi(w.y)}; } else { a1 = q1[64 * j];
#pragma unroll
                for (int ks = 1; ks < MOE_KS; ++ks) a1 = a1 + q1[(size_t)ks * 8 * 256 * D / 4 + 64 * j]; }
            v[j] = xr[64 * j] + gp[64 * j] * (a0 * w0 + a1 * w1); ss += (v[j][0] * v[j][0] + v[j][1] * v[j][1]) + (v[j][2] * v[j][2] + v[j][3] * v[j][3]); }
        const float rstd = 1.0f / sqrtf(wave_sum(ss) * (1.0f / D) + NORM_EPS);
        const f32x4* fn = (const f32x4*)p->in[I_FNORM] + F.lane; f32x4* o = (f32x4*)(p->out + (size_t)m * D) + F.lane;
#pragma unroll
        for (int j = 0; j < 8; ++j) o[64 * j] = v[j] * rstd * fn[64 * j];
    }
}

constexpr int PH_L0 = 1, PH_L1 = 12, PH_END = 23;
#define GRID_BAR() do { XcdBarrier bb_; bb_.bar = (unsigned*)(launder_kp(kp0)->ws + WS_CTL) + CW_BAR; bb_.x = xb_xcc_id(); bb_.st = (volatile LAS unsigned*)(ldsb + MISC_OFF) + 8; xcd_barrier(bb_); } while (0)
#define IN(k) (lo <= (k) && (k) < hi)
#define SEAM(k) do { if (IN(k) && IN((k) + 1)) { GRID_BAR(); if ((PROBE_DUP) == 999) GRID_BAR(); } } while (0)
#define RUNPH(id, ...) do { if ((PROBE_DUP) == (id)) { { __VA_ARGS__ } GRID_BAR(); } { __VA_ARGS__ } } while (0)
#define PHASE_BEGIN() const KP p = launder_kp(kp0); const Frame F = make_frame(ldsb); unsigned char* const ws = p->ws; (void)ws

template <int l>
__device__ __forceinline__ void layer_phases(const KP kp0, LAS unsigned char* const ldsb, const int lo, const int hi) {
        const int base = l == 0 ? PH_L0 : PH_L1;
        const bool ctx_out = (l == 0);
        const int mrows = ctx_out ? MT : NLAT;
        if (IN(base + 0)) { RUNPH(10, PHASE_BEGIN(); norm_phase<false, false, (l == 1) ? 1 : 0>(p, F, l, l == 0, p->in[I_NMIX] + (size_t)l * D, 0, 1, MT); if (l == 1) conv_drain(p, F, CV_L1_ITEMS);); SEAM(base + 0); }
        if (IN(base + 1)) {
            RUNPH(1,
            PHASE_BEGIN();
            pg8::Gemm g{(const bf16*)(ws + WS_H), (const bf16*)(ws + WS_WIN) + (size_t)l * NPI * D, D, D};
            pg8::DenseOrder S; S.init(MT / 256, NPI / 256, F.G, F.bid);
            pg8::EpiBf16 E{(bf16*)(ws + WS_P), NPI};
            pg8::gemm_phase<pg8::EpiBf16, pg8::DenseOrder>(F.lds, F.tid, g, S, E);
            );
            SEAM(base + 1);
        }
        if (IN(base + 2)) { PHASE_BEGIN(); prep_phase(p, F, l, ctx_out); if ((PROBE_DUP) == 2) { GRID_BAR(); prep_phase(p, F, l, ctx_out, 10); } if ((PROBE_DUP) == 21) { GRID_BAR(); prep_phase(p, F, l, ctx_out, 5, (WS_G - WS_P) / 2); } if ((PROBE_DUP) == 23) { GRID_BAR(); prep_phase(p, F, l, ctx_out, 2); } SEAM(base + 2); }
        if (IN(base + 3)) { RUNPH(3, PHASE_BEGIN(); mixer_phase(p, F, l, ctx_out);); SEAM(base + 3); }
        if (IN(base + 4)) { RUNPH(4, PHASE_BEGIN(); cd_combine_phase(p, F, l, ctx_out);); SEAM(base + 4); }
        if (IN(base + 5)) {
            if (l == 0 && (PROBE_DUP) == 5) {
              PHASE_BEGIN();
              { pg8::Gemm g{(const bf16*)(ws + WS_MIX), (const bf16*)(ws + WS_WOUT), D, D};
                pg8::DenseOrder S; S.init(NLAT / 256, D / 256, F.G, F.bid);
                pg8::EpiResid E{p->in[I_X], p->in[I_CTX], (float*)(ws + WS_X), (const float*)(ws + WS_MOD) + 2 * D};
                pg8::gemm_phase<pg8::EpiResid, pg8::DenseOrder>(F.lds, F.tid, g, S, E); }
              { pg8::Gemm g{(const bf16*)(ws + WS_MIX), (const bf16*)(ws + WS_WOUT), D / OUT_KS, D};
                pg8::SplitOrder S{NLAT / 256, NCTX / 256, D / 256, OUT_KS, 2 * D / OUT_KS, F.G, F.bid, nullptr};
                pg8::EpiPart E{(float*)(ws + WS_SPLIT), D, NLAT / 256, (size_t)NCTX * D};
                pg8::gemm_phase<pg8::EpiPart, pg8::SplitOrder>(F.lds, F.tid, g, S, E); }
              GRID_BAR();
            }
            PHASE_BEGIN();
            { pg8::Gemm g{(const bf16*)(ws + WS_MIX), (const bf16*)(ws + WS_WOUT) + (size_t)l * D * D, D, D};
              pg8::DenseOrder S; S.init(NLAT / 256, D / 256, F.G, F.bid);
              const float* xs = (const float*)(ws + WS_X);
              pg8::EpiResid E{l == 0 ? p->in[I_X] : xs, l == 0 ? p->in[I_CTX] : xs + (size_t)NLAT * D, (float*)(ws + WS_X), (const float*)(ws + WS_MOD) + (size_t)l * 5 * MODW + 2 * D};
              pg8::gemm_phase<pg8::EpiResid, pg8::DenseOrder>(F.lds, F.tid, g, S, E); }
            if (l == 0) {
              pg8::Gemm g{(const bf16*)(ws + WS_MIX), (const bf16*)(ws + WS_WOUT) + (size_t)l * D * D, D / OUT_KS, D};
              pg8::SplitOrder S{NLAT / 256, NCTX / 256, D / 256, OUT_KS, 2 * D / OUT_KS, F.G, F.bid, nullptr};
              pg8::EpiPart E{(float*)(ws + WS_SPLIT), D, NLAT / 256, (size_t)NCTX * D};
              pg8::gemm_phase<pg8::EpiPart, pg8::SplitOrder>(F.lds, F.tid, g, S, E); }
            SEAM(base + 5);
        }
        if (l == 0) {
            if (IN(base + 6)) { RUNPH(6, PHASE_BEGIN(); norm_phase<false, false, 2>(p, F, l, false, p->in[I_NFFN] + (size_t)l * D, 3, 4, MT);); SEAM(base + 6); }
            if (IN(base + 7)) {
                RUNPH(7,
                PHASE_BEGIN();
                pg8::Gemm g{(const bf16*)(ws + WS_H), (const bf16*)(ws + WS_W13), D, D};
                if (F.bid < FFU_GEMM_WGS) {
                    pg8::DenseOrder S; S.init(MT / 256, 2 * FFD / 256, FFU_GEMM_WGS, F.bid);
                    pg8::EpiSwiglu8 E{(unsigned char*)(ws + WS_G), FFD};
                    pg8::gemm_phase<pg8::EpiSwiglu8, pg8::DenseOrder>(F.lds, F.tid, g, S, E);
                }
                conv_drain(p, F, CV_L1_ITEMS + CV_FFU_ITEMS);
                );
                SEAM(base + 7);
            }
            if (IN(base + 8)) {
                PHASE_BEGIN();
                if ((PROBE_DUP) == 9) {
                  { pg8::Gemm g{(const bf16*)(ws + WS_G), (const bf16*)(ws + WS_W2), FFD / 2, FFD / 2};
                    pg8::DenseOrder S; S.init(NLAT / 256, D / 256, F.G, F.bid);
                    pg8::EpiF32 E{(float*)(ws + WS_Y), D};
                    pg8::gemm_phase<pg8::EpiF32, pg8::DenseOrder, true, true, true>(F.lds, F.tid, g, S, E); }
                  { pg8::Gemm g{(const bf16*)(ws + WS_G), (const bf16*)(ws + WS_W2), FFD / FFD_KS / 2, FFD / 2};
                    pg8::SplitOrder S{NLAT / 256, NCTX / 256, D / 256, FFD_KS, FFD / FFD_KS, F.G, F.bid, nullptr};
                    pg8::EpiPart E{(float*)(ws + WS_SPLIT), D, NLAT / 256, (size_t)NCTX * D};
                    pg8::gemm_phase<pg8::EpiPart, pg8::SplitOrder, true, true, true>(F.lds, F.tid, g, S, E); }
                  GRID_BAR();
                }
                { pg8::Gemm g{(const bf16*)(ws + WS_G), (const bf16*)(ws + WS_W2), FFD / 2, FFD / 2};
                  pg8::DenseOrder S; S.init(NLAT / 256, D / 256, F.G, F.bid);
                  const float* xs = (const float*)(ws + WS_X);
                  pg8::EpiResid E{xs, xs + (size_t)NLAT * D, (float*)(ws + WS_X), (const float*)(ws + WS_MOD) + (size_t)l * 5 * MODW + 5 * D};
                  pg8::gemm_phase<pg8::EpiResid, pg8::DenseOrder, true, true, true>(F.lds, F.tid, g, S, E); }
                { pg8::Gemm g{(const bf16*)(ws + WS_G), (const bf16*)(ws + WS_W2), FFD / FFD_KS / 2, FFD / 2};
                  pg8::SplitOrder S{NLAT / 256, NCTX / 256, D / 256, FFD_KS, FFD / FFD_KS, F.G, F.bid, nullptr};
                  pg8::EpiPart E{(float*)(ws + WS_SPLIT), D, NLAT / 256, (size_t)NCTX * D};
                  pg8::gemm_phase<pg8::EpiPart, pg8::SplitOrder, true, true, true>(F.lds, F.tid, g, S, E); }
                SEAM(base + 8);
            }
        } else {
            if (IN(base + 6)) { PHASE_BEGIN();
                if ((PROBE_DUP) == 16) { norm_phase<true, true>(p, F, l, false, p->in[I_NFFN] + (size_t)l * D, 3, 4, NLAT); GRID_BAR(); if (F.bid == 0 && F.tid < 8) ((unsigned*)(ws + WS_CTL))[CW_CNT + F.tid] = 0u; GRID_BAR(); }
                norm_phase<true, true>(p, F, l, false, p->in[I_NFFN] + (size_t)l * D, 3, 4, NLAT); SEAM(base + 6); }
            if (IN(base + 7)) { PHASE_BEGIN();
                if ((PROBE_DUP) == 17) { moe_gather_phase(p, F); GRID_BAR(); if (F.bid == 0 && F.tid < 8) ((unsigned*)(ws + WS_CTL))[CW_CUR + F.tid] = 0u; GRID_BAR(); }
                moe_gather_phase(p, F); conv_drain(p, F, CV_L1_ITEMS + CV_FFU_ITEMS);
                if ((PROBE_DUP) == 107) { GRID_BAR(); if (F.bid == 0 && F.tid == 0) __hip_atomic_store((unsigned*)(ws + WS_CTL) + CW_CONV, (unsigned)CV_L1_ITEMS, __ATOMIC_RELAXED, __HIP_MEMORY_SCOPE_AGENT); GRID_BAR(); conv_drain(p, F, CV_DEF_ITEMS); }
                SEAM(base + 7); }
            if (IN(base + 8)) {
                RUNPH(108,
                PHASE_BEGIN();
                const unsigned* ctl = (const unsigned*)(ws + WS_CTL);
                volatile LAS unsigned char* pe = (volatile LAS unsigned char*)(F.lds + MISC_OFF + 256);
                const int np = (int)ctl[CW_PANEL];
                if (F.tid < 128) pe[F.tid] = (unsigned char)(F.tid < np ? ctl[CW_PANEL + 1 + F.tid] : 0u);
                __syncthreads();
                pg8::Gemm g{(const bf16*)(ws + WS_HS), (const bf16*)(ws + WS_W13E), D / 2, D / 2};
                const int units = np * (2 * FFE / 256), rounds = (units + F.G - 1) / F.G + 1, gw = (((units + rounds - 1) / rounds) + 7) & ~7;
                if (F.bid < gw) {
                    pg8::MoeOrder S; S.init(np, 2 * FFE / 256, gw, F.bid); S.pe = pe;
                    pg8::EpiSwiglu8 E{(unsigned char*)(ws + WS_G), FFE};
                    pg8::gemm_phase<pg8::EpiSwiglu8, pg8::MoeOrder, true, true, true>(F.lds, F.tid, g, S, E);
                }
                conv_drain(p, F, CV_DEF_ITEMS);
                );
                SEAM(base + 8);
            }
            if (IN(base + 9)) {
                RUNPH(109,
                PHASE_BEGIN();
                const unsigned* ctl = (const unsigned*)(ws + WS_CTL);
                volatile LAS unsigned char* pe = (volatile LAS unsigned char*)(F.lds + MISC_OFF + 256);
                const int np = (int)ctl[CW_PANEL];
                if (F.tid < 128) pe[F.tid] = (unsigned char)(F.tid < np ? ctl[CW_PANEL + 1 + F.tid] : 0u);
                __syncthreads();
                const int nfull = np < MOE_FULL_PANELS ? np : MOE_FULL_PANELS;
                { pg8::Gemm g{(const bf16*)(ws + WS_G), (const bf16*)(ws + WS_W2E), FFE / 2, FFE / 2};
                  pg8::MoeOrder S; S.init(nfull, D / 256, F.G, F.bid); S.pe = pe;
                  pg8::EpiBf16 E{(bf16*)(ws + WS_Y), D};
                  pg8::gemm_phase<pg8::EpiBf16, pg8::MoeOrder, true, true, true>(F.lds, F.tid, g, S, E); }
                if (np > nfull) {
                  pg8::Gemm g{(const bf16*)(ws + WS_G), (const bf16*)(ws + WS_W2E), FFE / MOE_KS / 2, FFE / 2};
                  pg8::SplitOrder S{MOE_FULL_PANELS, np - nfull, D / 256, MOE_KS, FFE / MOE_KS, F.G, F.bid, pe};
                  pg8::EpiPart E{(float*)(ws + WS_SPLIT), D, MOE_FULL_PANELS, (size_t)8 * 256 * D};
                  pg8::gemm_phase<pg8::EpiPart, pg8::SplitOrder, true, true, true>(F.lds, F.tid, g, S, E); }
                );
                SEAM(base + 9);
            }
            if (IN(base + 10)) { RUNPH(22, PHASE_BEGIN(); final_phase(p, F);); }
        }
}

__global__ void __launch_bounds__(NTHR, 2) fwd_kernel(Params pv) {
    extern __shared__ __attribute__((aligned(16))) unsigned char lds_raw[];
    LAS unsigned char* const ldsb = (LAS unsigned char*)lds_raw;
    const KP kp0 = (KP)__builtin_amdgcn_kernarg_segment_ptr();
    { volatile LAS unsigned* MISC = (volatile LAS unsigned*)(ldsb + MISC_OFF);
      for (int u = threadIdx.x; u < 256; u += NTHR) MISC[u] = 0u; }
    __syncthreads();
    const int lo = kp0->ph_lo, hi = kp0->ph_hi;
    if ((hi - lo) > 1) (void)xcd_barrier_post((unsigned*)(kp0->ws + WS_CTL) + CW_BAR, (volatile LAS unsigned*)(ldsb + MISC_OFF) + 8);
    if (IN(0)) { RUNPH(0, PHASE_BEGIN(); p0_prologue(p, F);); SEAM(0); }
    layer_phases<0>(kp0, ldsb, lo, hi);
    layer_phases<1>(kp0, ldsb, lo, hi);
}
#undef IN
#undef SEAM
#undef GRID_BAR
#undef RUNPH
#undef PHASE_BEGIN

extern "C" void kernel_launch(void* const* d_in, const int* in_sizes, int n_in, void* d_out, int out_size, void* d_ws, size_t ws_size, hipStream_t stream) {
    static int grid = 0;
    if (grid == 0) {
        if (n_in != 26 || out_size != NLAT * D || ws_size < WS_END) { fprintf(stderr, "kernel_launch: unexpected shapes (n_in %d out %d ws %zu need %zu)\n", n_in, out_size, ws_size, (size_t)WS_END); grid = -1; return; }
        int dev = 0, cus = 0, per_cu = 0;
        if (hipGetDevice(&dev) != hipSuccess || hipDeviceGetAttribute(&cus, hipDeviceAttributeMultiprocessorCount, dev) != hipSuccess) { grid = -1; return; }
        if (hipFuncSetAttribute((const void*)fwd_kernel, hipFuncAttributeMaxDynamicSharedMemorySize, LDS_BYTES) != hipSuccess) { fprintf(stderr, "kernel_launch: hipFuncSetAttribute failed\n"); grid = -1; return; }
        if (hipOccupancyMaxActiveBlocksPerMultiprocessor(&per_cu, (const void*)fwd_kernel, NTHR, LDS_BYTES) != hipSuccess || per_cu < 1) fprintf(stderr, "kernel_launch: occupancy query says %d\n", per_cu);
        (void)hipGetLastError();
        grid = cus;
    }
    if (grid < 0) return;
    (void)hipMemsetAsync((char*)d_ws + WS_CTL, 0, CTL_BYTES, stream);
    Params p{};
    for (int i = 0; i < 26; ++i) p.in[i] = (const float*)d_in[i];
    p.out = (float*)d_out; p.ws = (unsigned char*)d_ws;
#if MK_ONE_LAUNCH
    p.ph_lo = 0; p.ph_hi = PH_END;
    hipLaunchKernelGGL(fwd_kernel, dim3(grid), dim3(NTHR), LDS_BYTES, stream, p);
#else
    const int phases[] = {0, 1, 2, 3, 4, 5, 6, 7, 8, 9, 12, 13, 14, 15, 16, 17, 18, 19, 20, 21, 22};
    for (int i = 0; i < (int)(sizeof(phases) / sizeof(phases[0])); ++i) { p.ph_lo = phases[i]; p.ph_hi = phases[i] + 1; hipLaunchKernelGGL(fwd_kernel, dim3(grid), dim3(NTHR), LDS_BYTES, stream, p); }
#endif
}
```

```cpp
#include <hip/hip_runtime.h>
#include <cstdio>
#include <cstdint>

#ifndef PROBE_DUP
#define PROBE_DUP -1
#endif
#ifndef MK_ONE_LAUNCH
#define MK_ONE_LAUNCH 1
#endif
#ifndef FFU_FP8
#define FFU_FP8 0
#endif

#define GAS __attribute__((address_space(1)))
#define LAS __attribute__((address_space(3)))
typedef unsigned short bf16;
typedef short bf16x8 __attribute__((ext_vector_type(8)));
typedef float f32x4 __attribute__((ext_vector_type(4)));
typedef float f32x2 __attribute__((ext_vector_type(2)));
typedef unsigned u32x4 __attribute__((ext_vector_type(4)));
typedef unsigned u32x2 __attribute__((ext_vector_type(2)));

constexpr int D = 2048, NB = 4, SEQ = 2048, CTXL = 256, NLAT = NB * SEQ, NCTX = NB * CTXL, MT = NLAT + NCTX;
constexpr int KEYS = CTXL + SEQ;
constexpr int INW = 7200;
constexpr int NPI = 7168;
constexpr int FFD = 5632, FFE = 7168, NEXP = 8;
constexpr int MODW = 6 * D;
constexpr int A_Q = 0, A_K = 512, A_V = 1024, B_Q = 1536, B_K = 2048, B_V = 2560, C_Q = 3072, C_I = 3584, C_FF = 4096, C_FB = 4608, C_G = 5120,
              D_Q = 5632, D_K = 5888, D_V = 6144, D_R = 6656;
constexpr int Z_SRC = 6656;
constexpr float LOG2E = 1.4426950408889634f;
constexpr float NORM_EPS = 1e-6f;

constexpr size_t MiB = 1u << 20;
constexpr size_t al(size_t x) { return (x + 255) & ~(size_t)255; }
constexpr size_t WS_CTL = 0, CTL_BYTES = 1 * MiB;
constexpr size_t WS_MOD = WS_CTL + CTL_BYTES;
constexpr size_t WS_ROUTE = WS_MOD + al((size_t)2 * 5 * MODW * 4);
constexpr size_t WS_POS = WS_ROUTE + al((size_t)NLAT * 16);
constexpr size_t WS_Z = WS_POS + al((size_t)NLAT * 8);
constexpr size_t WS_WZT = WS_Z + al((size_t)MT * 32 * 4);
constexpr size_t WS_WIN = WS_WZT + al((size_t)2 * 32 * D * 2);
constexpr size_t WS_WOUT = WS_WIN + al((size_t)2 * NPI * D * 2);
constexpr size_t WS_W13 = WS_WOUT + al((size_t)2 * D * D * 2);
constexpr size_t WS_W2 = WS_W13 + al((size_t)2 * FFD * D * 2);
constexpr size_t WS_W13E = WS_W2 + al((size_t)D * FFD * 2);
constexpr size_t WS_W2E = WS_W13E + al((size_t)NEXP * 2 * FFE * D * 2);
constexpr size_t WS_X = WS_W2E + al((size_t)NEXP * D * FFE * 2);
constexpr size_t WS_H = WS_X + al((size_t)MT * D * 4);
constexpr size_t WS_P = WS_H + al((size_t)MT * D * 2);
constexpr size_t WS_MIX = WS_P + al((size_t)MT * NPI * 2);
constexpr size_t WS_VTA = WS_MIX + al((size_t)MT * D * 2);
constexpr size_t WS_VTB = WS_VTA + al((size_t)NB * 8 * 64 * KEYS * 2);
constexpr size_t WS_OC = WS_VTB + al((size_t)NB * 8 * 64 * KEYS * 2);
constexpr size_t WS_OD = WS_OC + al((size_t)2 * MT * 512 * 4);
constexpr int MPAD = 18432;
constexpr size_t WS_G = WS_OD + al((size_t)2 * MT * 512 * 4);
constexpr size_t WS_LG = WS_G + al((size_t)MPAD * FFE * 2);
constexpr size_t WS_HLA = WS_LG + al((size_t)2 * MT * 256 * 4);
constexpr int FFD_KS = 11, MOE_KS = 7, MOE_FULL_PANELS = 64, OUT_KS = 4;
constexpr size_t WS_SPLIT = WS_HLA + al((size_t)2 * MT * 512 * 4);
constexpr size_t WS_KNA = WS_SPLIT + al((size_t)MOE_KS * 8 * 256 * D * 4);
constexpr size_t WS_KNB = WS_KNA + al((size_t)NB * 16 * KEYS * 4);
constexpr size_t WS_BCNT = WS_KNB + al((size_t)NB * 8 * KEYS * 4);
constexpr size_t WS_END = WS_BCNT + al((size_t)1024 * 8 * 4);
constexpr size_t WS_Y = WS_P;
constexpr size_t WS_HS = WS_OC;
static_assert((size_t)MPAD * D * 4 <= (size_t)MT * NPI * 2 + (size_t)MT * D * 2 + 512, "Y alias");
static_assert((size_t)MPAD * D * 2 <= (size_t)4 * MT * 512 * 4, "HS alias");
constexpr int CW_BAR = 4096;
constexpr int CW_CNT = 8192;
constexpr int CW_CUR = 8192 + 64;
constexpr int CW_PANEL = 8192 + 128;
constexpr int CW_CONV = 12288;
constexpr int CW_CONV0 = 12352;
constexpr int CW_KMAX = 24576;
constexpr int CW_QUEUE = 16384;

constexpr int RING_BYTES = 131072;
constexpr int MISC_OFF = RING_BYTES;
constexpr int LDS_BYTES = 147456;
constexpr int NWAVES = 8, NTHR = 512;

__device__ __forceinline__ float bf2f(bf16 b) { return __uint_as_float(((unsigned)b) << 16); }
__device__ __forceinline__ float bflo(unsigned w) { return __uint_as_float(w << 16); }
__device__ __forceinline__ float bfhi(unsigned w) { return __uint_as_float(w & 0xffff0000u); }
typedef __bf16 bf16x2_t __attribute__((ext_vector_type(2)));
__device__ __forceinline__ unsigned cvt_pk_bf16(float lo, float hi) { const f32x2 v = {lo, hi}; return __builtin_bit_cast(unsigned, __builtin_convertvector(v, bf16x2_t)); }
__device__ __forceinline__ float wave_sum(float v) {
#pragma unroll
    for (int o = 1; o < 64; o <<= 1) v += __shfl_xor(v, o);
    return v;
}
__device__ __forceinline__ unsigned cvt4_fp8(float a, float b, float c, float d) { unsigned w = 0; w = __builtin_amdgcn_cvt_pk_fp8_f32(a, b, w, false); w = __builtin_amdgcn_cvt_pk_fp8_f32(c, d, w, true); return w; }
constexpr float W8_SCALE = 64.0f;
__device__ __forceinline__ float xmax16(float x) { const unsigned u = __float_as_uint(x); const auto r = __builtin_amdgcn_permlane16_swap(u, u, false, false); return fmaxf(__uint_as_float(r[0]), __uint_as_float(r[1])); }
__device__ __forceinline__ float xmax32(float x) { const unsigned u = __float_as_uint(x); const auto r = __builtin_amdgcn_permlane32_swap(u, u, false, false); return fmaxf(__uint_as_float(r[0]), __uint_as_float(r[1])); }
__device__ __forceinline__ float xsum16(float x) { const unsigned u = __float_as_uint(x); const auto r = __builtin_amdgcn_permlane16_swap(u, u, false, false); return __uint_as_float(r[0]) + __uint_as_float(r[1]); }
__device__ __forceinline__ float xsum32(float x) { const unsigned u = __float_as_uint(x); const auto r = __builtin_amdgcn_permlane32_swap(u, u, false, false); return __uint_as_float(r[0]) + __uint_as_float(r[1]); }
__device__ __forceinline__ float fexp2(float x) { return __builtin_amdgcn_exp2f(x); }
__device__ __forceinline__ float fsigmoid(float x) { return 1.0f / (1.0f + __expf(-x)); }
__device__ __forceinline__ float fsilu(float x) { return x / (1.0f + __expf(-x)); }
#define LDS_WAIT() asm volatile("s_waitcnt lgkmcnt(0)" ::: "memory")

#define XB_TMO      128
#define XB_XCNT(j)  (256  + 64 * (j))
#define XB_XSUB(j)  (1280 + 64 * (j))
#define XB_XGEN(j)  (2304 + 64 * (j))
#define XB_TOP      3328
#define XB_TOPGEN   3392
#define XCD_BAR_WORDS 3456
#define XB_SPIN_CAP (1u << 18)
__device__ __forceinline__ unsigned xb_ld(unsigned* p)              { return __hip_atomic_load(p, __ATOMIC_RELAXED, __HIP_MEMORY_SCOPE_AGENT); }
__device__ __forceinline__ unsigned xb_add(unsigned* p, unsigned v) { return __hip_atomic_fetch_add(p, v, __ATOMIC_RELAXED, __HIP_MEMORY_SCOPE_AGENT); }
__device__ __forceinline__ unsigned xb_xcc_id() { return (unsigned)__builtin_amdgcn_s_getreg((3 << 11) | 20) & 0xFu; }
#define XB_SPIN(cond, bar) do { unsigned _sp = 0; while (cond) { __builtin_amdgcn_s_sleep(1); \
    if ((++_sp & 255u) == 0u) { if (xb_ld(&(bar)[XB_TMO])) break; if (_sp > XB_SPIN_CAP) { atomicAdd(&(bar)[XB_TMO], 1u); break; } } } } while (0)
struct XcdBarrier { unsigned* bar; unsigned x; volatile LAS unsigned* st; };
__device__ __forceinline__ XcdBarrier xcd_barrier_post(unsigned* bar, volatile LAS unsigned* st) {
    XcdBarrier b; b.bar = bar; b.x = xb_xcc_id(); b.st = st;
    if (threadIdx.x == 0) (void)xb_add(&bar[XB_XCNT(b.x)], 1u);
    return b;
}
__device__ __forceinline__ void xcd_barrier_complete(unsigned* bar, unsigned x, unsigned& nloc, unsigned& nx) {
    const unsigned G = gridDim.x * gridDim.y * gridDim.z;
    unsigned sum, cnt, mine, sp = 0u;
    for (;;) {
        sum = 0u; cnt = 0u; mine = 0u;
#pragma unroll
        for (unsigned j = 0; j < 16; ++j) { const unsigned c = xb_ld(&bar[XB_XCNT(j)]); sum += c; cnt += (c > 0u) ? 1u : 0u; mine = (j == x) ? c : mine; }
        if (sum == G) break;
        __builtin_amdgcn_s_sleep(1);
        if ((++sp & 255u) == 0u) { if (xb_ld(&bar[XB_TMO])) break; if (sp > XB_SPIN_CAP) { atomicAdd(&bar[XB_TMO], 1u); break; } }
    }
    nloc = mine > 0u ? mine : 1u; nx = cnt > 0u ? cnt : 1u;
}
__device__ __forceinline__ void xcd_barrier(const XcdBarrier& b) {
    asm volatile("s_waitcnt vmcnt(0)" ::: "memory");
    __syncthreads();
    if (threadIdx.x == 0) {
        unsigned* bar = b.bar;
        __builtin_amdgcn_s_waitcnt(0);
        unsigned nloc = b.st[0], nx = b.st[1];
        if (nloc == 0u) { xcd_barrier_complete(bar, b.x, nloc, nx); b.st[0] = nloc; b.st[1] = nx; }
        const unsigned old = xb_add(&bar[XB_XSUB(b.x)], 1u);
        const unsigned gen = old / nloc;
        if (old + 1u == (gen + 1u) * nloc) {
            __builtin_amdgcn_fence(__ATOMIC_RELEASE, "agent");
            asm volatile("s_waitcnt vmcnt(0)" ::: "memory");
            const unsigned og = xb_add(&bar[XB_TOP], 1u);
            const unsigned tg = og / nx;
            if (og + 1u == (tg + 1u) * nx) xb_add(&bar[XB_TOPGEN], 1u);
            else XB_SPIN(xb_ld(&bar[XB_TOPGEN]) == tg, bar);
            __builtin_amdgcn_fence(__ATOMIC_ACQUIRE, "agent");
            xb_add(&bar[XB_XGEN(b.x)], 1u);
            asm volatile("s_waitcnt vmcnt(0)" ::: "memory");
        } else {
            XB_SPIN(xb_ld(&bar[XB_XGEN(b.x)]) == gen, bar);
            __builtin_amdgcn_fence(__ATOMIC_ACQUIRE, "agent");
            asm volatile("s_waitcnt vmcnt(0)" ::: "memory");
        }
    }
    __syncthreads();
}

namespace pg8 {
#define PG8_LAS __attribute__((address_space(3)))
constexpr int BM = 256, BK = 64, HALF = 128, HTB = HALF * BK * 2, STAGE_BYTES = 8 * HTB, NXCD = 8, WGM = 8;
__host__ __device__ __forceinline__ int lds_byte(int r, int c) { const int st = (r >> 4) * 2 + (c >> 5), rr = r & 15, cc = c & 31, ob = rr * 64 + cc * 2; return st * 1024 + (ob ^ (((ob >> 9) & 1) << 5)); }
__host__ __device__ __forceinline__ void stage_rc(int b, int& R, int& C) { const int st = b / 1024, sb = b % 1024, swz = sb ^ (((sb >> 9) & 1) << 5); R = (st >> 1) * 16 + swz / 64; C = (st & 1) * 32 + (swz % 64) / 2; }
__host__ __device__ __forceinline__ int perm32(int rho) { const int n = rho >> 4, i = rho & 15; return 8 * (i >> 2) + 4 * n + (i & 3); }

typedef int i32x4 __attribute__((ext_vector_type(4)));
typedef int i32x8 __attribute__((ext_vector_type(8)));
typedef short s16x16 __attribute__((ext_vector_type(16)));
__device__ __forceinline__ i32x8 cat8(const bf16x8 lo, const bf16x8 hi) { const i32x4 a = __builtin_bit_cast(i32x4, lo), b = __builtin_bit_cast(i32x4, hi); return __builtin_shufflevector(a, b, 0, 1, 2, 3, 4, 5, 6, 7); }
struct Unit { int pm, pn, pb, koff, ks; };
struct Gemm { const bf16* A; const bf16* Bt; int K; int ld; };

struct TileOrder {
    int nM, nN, nwg, G, c;
    __device__ __forceinline__ void init(int nM_, int nN_, int G_, int c_) { nM = nM_; nN = nN_; nwg = nM * nN; G = G_; c = c_; }
    __device__ __forceinline__ bool tile(int i, int& pm, int& pn) const {
        const long L = (long)i * G + c; if (L >= nwg) return false;
        int wgid = (int)L; { const int q = nwg / NXCD, r = nwg % NXCD, xcd = wgid % NXCD, off = wgid / NXCD; wgid = (xcd < r ? xcd * (q + 1) : r * (q + 1) + (xcd - r) * q) + off; }
        const int nig = WGM * nN, gid = wgid / nig, fm = gid * WGM, gsz = (nM - fm) < WGM ? (nM - fm) : WGM;
        pm = fm + ((wgid % nig) % gsz); pn = (wgid % nig) / gsz; return true;
    }
};
struct DenseOrder : TileOrder {
    __device__ __forceinline__ bool next(int i, Unit& u) const { if (!tile(i, u.pm, u.pn)) return false; u.pb = u.pn; u.koff = 0; u.ks = 0; return true; }
    __device__ __forceinline__ void a_ready(const Unit&) const {}
    __device__ __forceinline__ void done(const Unit&) const {}
};
struct MoeOrder : TileOrder {
    const volatile PG8_LAS unsigned char* pe;
    __device__ __forceinline__ bool next(int i, Unit& u) const { if (!tile(i, u.pm, u.pn)) return false; u.pb = (int)pe[u.pm] * nN + u.pn; u.koff = 0; u.ks = 0; return true; }
    __device__ __forceinline__ void a_ready(const Unit&) const {}
    __device__ __forceinline__ void done(const Unit&) const {}
};

struct SplitOrder {
    int pm0, npan, nN, nks, kbytes, G, c; const volatile PG8_LAS unsigned char* pe;
    __device__ __forceinline__ bool next(int i, Unit& u) const {
        const long L = (long)i * G + c; if (L >= (long)npan * nN * nks) return false;
        const int l = (int)L; u.ks = l % nks; const int t = l / nks; u.pn = t % nN; u.pm = pm0 + t / nN; u.koff = u.ks * kbytes;
        u.pb = pe ? (int)pe[u.pm] * nN + u.pn : u.pn; return true;
    }
    __device__ __forceinline__ void a_ready(const Unit&) const {}
    __device__ __forceinline__ void done(const Unit&) const {}
};
struct EpiBf16 {
    static constexpr bool PERM = true, AFTER_DRAIN = false;
    bf16* O; int ldc;
    __device__ __forceinline__ void operator()(const f32x4 (&acc)[2][2][4][2], const Unit& u, int wr, int wc, int fr, int fq) const {
        const int row0 = u.pm * BM + wr * 64 + fr, col0 = u.pn * BM + wc * 32 + 8 * fq;
#pragma unroll
        for (int ai = 0; ai < 2; ++ai)
#pragma unroll
            for (int m = 0; m < 4; ++m) { bf16* rowp = O + (size_t)(row0 + ai * HALF + m * 16) * ldc + col0;
#pragma unroll
                for (int bj = 0; bj < 2; ++bj) { const f32x4 v0 = acc[ai][bj][m][0], v1 = acc[ai][bj][m][1];
                    u32x4 w; w.x = cvt_pk_bf16(v0[0], v0[1]); w.y = cvt_pk_bf16(v0[2], v0[3]); w.z = cvt_pk_bf16(v1[0], v1[1]); w.w = cvt_pk_bf16(v1[2], v1[3]);
                    *(u32x4*)(rowp + bj * HALF) = w; } }
    }
};
struct EpiSwiglu {
    static constexpr bool PERM = true, AFTER_DRAIN = false;
    bf16* O; int ldc;
    __device__ __forceinline__ void operator()(const f32x4 (&acc)[2][2][4][2], const Unit& u, int wr, int wc, int fr, int fq) const {
        const int row0 = u.pm * BM + wr * 64 + fr, col0 = u.pn * HALF + wc * 32 + 8 * fq;
#pragma unroll
        for (int ai = 0; ai < 2; ++ai)
#pragma unroll
            for (int m = 0; m < 4; ++m) { bf16* rowp = O + (size_t)(row0 + ai * HALF + m * 16) * ldc + col0;
                float o[8];
#pragma unroll
                for (int n = 0; n < 2; ++n)
#pragma unroll
                    for (int j = 0; j < 4; ++j) { const float a = acc[ai][0][m][n][j], b = acc[ai][1][m][n][j]; o[n * 4 + j] = a * __builtin_amdgcn_rcpf(1.0f + __expf(-a)) * b; }
                u32x4 w; w.x = cvt_pk_bf16(o[0], o[1]); w.y = cvt_pk_bf16(o[2], o[3]); w.z = cvt_pk_bf16(o[4], o[5]); w.w = cvt_pk_bf16(o[6], o[7]);
                *(u32x4*)rowp = w; }
    }
};
struct EpiSwiglu8 {
    static constexpr bool PERM = true, AFTER_DRAIN = false;
    unsigned char* O; int ldc;
    __device__ __forceinline__ void operator()(const f32x4 (&acc)[2][2][4][2], const Unit& u, int wr, int wc, int fr, int fq) const {
        const int row0 = u.pm * BM + wr * 64 + fr, col0 = u.pn * HALF + wc * 32 + 8 * fq;
#pragma unroll
        for (int ai = 0; ai < 2; ++ai)
#pragma unroll
            for (int m = 0; m < 4; ++m) { unsigned char* rowp = O + (size_t)(row0 + ai * HALF + m * 16) * ldc + col0;
                float o[8];
#pragma unroll
                for (int n = 0; n < 2; ++n)
#pragma unroll
                    for (int j = 0; j < 4; ++j) { const float a = acc[ai][0][m][n][j], b = acc[ai][1][m][n][j]; o[n * 4 + j] = a * __builtin_amdgcn_rcpf(1.0f + __expf(-a)) * b; }
                u32x2 w; w.x = cvt4_fp8(o[0], o[1], o[2], o[3]); w.y = cvt4_fp8(o[4], o[5], o[6], o[7]);
                *(u32x2*)rowp = w; }
    }
};
struct EpiResid {
    static constexpr bool PERM = false, AFTER_DRAIN = false;
    const float* res_lat; const float* res_ctx; float* X; const float* gate;
    __device__ __forceinline__ void operator()(const f32x4 (&acc)[2][2][4][2], const Unit& u, int wr, int wc, int fr, int fq) const {
        const int row0 = u.pm * BM + wr * 64 + fr, col0 = u.pn * BM + wc * 32 + 4 * fq;
        const int ci = u.pm < 32 ? (u.pm >> 3) : 4;
        const float* gp = gate + (size_t)ci * MODW + col0;
        f32x4 gv[2][2];
#pragma unroll
        for (int bj = 0; bj < 2; ++bj)
#pragma unroll
            for (int n = 0; n < 2; ++n) gv[bj][n] = *(const f32x4*)(gp + bj * HALF + n * 16);
#pragma unroll
        for (int ai = 0; ai < 2; ++ai)
#pragma unroll
            for (int m = 0; m < 4; ++m) { const int r = row0 + ai * HALF + m * 16;
                const float* rp = (r < NLAT ? res_lat + (size_t)r * D : res_ctx + (size_t)(r - NLAT) * D) + col0; float* xp = X + (size_t)r * D + col0;
#pragma unroll
                for (int bj = 0; bj < 2; ++bj)
#pragma unroll
                    for (int n = 0; n < 2; ++n) { const f32x4 rv = *(const f32x4*)(rp + bj * HALF + n * 16); *(f32x4*)(xp + bj * HALF + n * 16) = rv + gv[bj][n] * acc[ai][bj][m][n]; } }
    }
};
struct EpiF32 {
    static constexpr bool PERM = false, AFTER_DRAIN = false;
    float* C; int ldc;
    __device__ __forceinline__ void operator()(const f32x4 (&acc)[2][2][4][2], const Unit& u, int wr, int wc, int fr, int fq) const {
        const int row0 = u.pm * BM + wr * 64 + fr, col0 = u.pn * BM + wc * 32 + 4 * fq;
#pragma unroll
        for (int ai = 0; ai < 2; ++ai)
#pragma unroll
            for (int m = 0; m < 4; ++m) { float* rowp = C + (size_t)(row0 + ai * HALF + m * 16) * ldc + col0;
#pragma unroll
                for (int bj = 0; bj < 2; ++bj)
#pragma unroll
                    for (int n = 0; n < 2; ++n) *(f32x4*)(rowp + bj * HALF + n * 16) = acc[ai][bj][m][n]; }
    }
};

struct EpiPart {
    static constexpr bool PERM = false, AFTER_DRAIN = false;
    float* C; int ldc; int pm0; size_t slab;
    __device__ __forceinline__ void operator()(const f32x4 (&acc)[2][2][4][2], const Unit& u, int wr, int wc, int fr, int fq) const {
        const int row0 = (u.pm - pm0) * BM + wr * 64 + fr, col0 = u.pn * BM + wc * 32 + 4 * fq;
        float* base = C + (size_t)u.ks * slab;
#pragma unroll
        for (int ai = 0; ai < 2; ++ai)
#pragma unroll
            for (int m = 0; m < 4; ++m) { float* rowp = base + (size_t)(row0 + ai * HALF + m * 16) * ldc + col0;
#pragma unroll
                for (int bj = 0; bj < 2; ++bj)
#pragma unroll
                    for (int n = 0; n < 2; ++n) *(f32x4*)(rowp + bj * HALF + n * 16) = acc[ai][bj][m][n]; }
    }
};
template <class Epi, class Sched, bool ALIGN_EPI = true, bool SP2 = true, bool FP8 = false>
__device__ __forceinline__ void gemm_phase(PG8_LAS unsigned char* lds, const int tid, const Gemm g, const Sched& S, const Epi& E) {
    const int wid = __builtin_amdgcn_readfirstlane(tid >> 6), lane = tid & 63, wr = wid >> 2, wc = wid & 3, fr = lane & 15, fq = lane >> 4;
    const int K = g.ld, nt = g.K / BK;
    unsigned voffA[2], voffB[2];
#pragma unroll
    for (int i = 0; i < 2; ++i) { int R, C; stage_rc(tid * 16 + i * 8192, R, C); const int Rb = Epi::PERM ? ((R & ~31) + perm32(R & 31)) : R;
        voffA[i] = (unsigned)(R * K + C) * 2u; voffB[i] = (unsigned)(Rb * K + C) * 2u; }
    const size_t kstep = (size_t)(BK * 2);
    const size_t hstep = (size_t)HALF * K * 2;
    const size_t tstep = 2 * hstep;
    const unsigned ldsw = (unsigned)wid * 1024u;
    const int aoff = FP8 ? lds_byte(wr * 64 + fr, fq * 16) : lds_byte(wr * 64 + fr, fq * 8), boff = FP8 ? lds_byte(wc * 32 + fr, fq * 16) : lds_byte(wc * 32 + fr, fq * 8);
#define PG8_SA(b, h) (((b) * 2 + (h)) * HTB)
#define PG8_SB(b, h) ((4 + (b) * 2 + (h)) * HTB)
#define PG8_STAGE(bufoff, gbase, voff) do { _Pragma("unroll") for (int _i = 0; _i < 2; ++_i) \
        __builtin_amdgcn_global_load_lds((const unsigned*)((const char*)(gbase) + (voff)[_i]), (PG8_LAS unsigned*)(lds + (bufoff) + ldsw + _i * 8192), 16, 0, 0); } while (0)
#define PG8_LDA(dst, b, h) do { _Pragma("unroll") for (int m = 0; m < 4; ++m) { if constexpr (FP8) dst[m] = cat8(*(const PG8_LAS bf16x8*)(lds + PG8_SA(b, h) + aoff + m * 2048), *(const PG8_LAS bf16x8*)(lds + PG8_SA(b, h) + aoff + m * 2048 + 16)); \
        else dst[m] = cat8(*(const PG8_LAS bf16x8*)(lds + PG8_SA(b, h) + aoff + m * 2048), *(const PG8_LAS bf16x8*)(lds + PG8_SA(b, h) + aoff + m * 2048 + 1024)); } } while (0)
#define PG8_LDB(dst, b, h) do { _Pragma("unroll") for (int n = 0; n < 2; ++n) { if constexpr (FP8) dst[n] = cat8(*(const PG8_LAS bf16x8*)(lds + PG8_SB(b, h) + boff + n * 2048), *(const PG8_LAS bf16x8*)(lds + PG8_SB(b, h) + boff + n * 2048 + 16)); \
        else dst[n] = cat8(*(const PG8_LAS bf16x8*)(lds + PG8_SB(b, h) + boff + n * 2048), *(const PG8_LAS bf16x8*)(lds + PG8_SB(b, h) + boff + n * 2048 + 1024)); } } while (0)
#define PG8_K0(x) __builtin_bit_cast(bf16x8, __builtin_shufflevector(x, x, 0, 1, 2, 3))
#define PG8_K1(x) __builtin_bit_cast(bf16x8, __builtin_shufflevector(x, x, 4, 5, 6, 7))
#define PG8_MMA(ai, bj, At, Bt) do { __builtin_amdgcn_s_setprio(1); \
        if constexpr (FP8) { _Pragma("unroll") for (int m = 0; m < 4; ++m) _Pragma("unroll") for (int n = 0; n < 2; ++n) \
            asm volatile("v_mfma_scale_f32_16x16x128_f8f6f4 %0, %1, %2, %0, %3, %4 op_sel_hi:[0,0,0]" : "+v"(acc[ai][bj][m][n]) : "v"(Bt[n]), "v"(At[m]), "v"(sc_w), "v"(sc_a)); } \
        else { _Pragma("unroll") for (int m = 0; m < 4; ++m) _Pragma("unroll") for (int n = 0; n < 2; ++n) { \
            acc[ai][bj][m][n] = __builtin_amdgcn_mfma_f32_16x16x32_bf16(PG8_K0(Bt[n]), PG8_K0(At[m]), acc[ai][bj][m][n], 0, 0, 0); \
            acc[ai][bj][m][n] = __builtin_amdgcn_mfma_f32_16x16x32_bf16(PG8_K1(Bt[n]), PG8_K1(At[m]), acc[ai][bj][m][n], 0, 0, 0); } } \
        __builtin_amdgcn_s_setprio(0); } while (0)
#define PG8_WAIT_V(n) asm volatile("s_waitcnt vmcnt(" #n ")" ::: "memory")
#define PG8_WAIT_L(n) asm volatile("s_waitcnt lgkmcnt(" #n ")" ::: "memory")
#define PG8_BAR __builtin_amdgcn_s_barrier()
#define PG8_SCHED __builtin_amdgcn_sched_barrier(0)
    Unit cur, nxt; int ui = 0;
    if (!S.next(0, cur)) return;
    f32x4 acc[2][2][4][2];
#pragma unroll
    for (int a = 0; a < 2; ++a)
#pragma unroll
        for (int b = 0; b < 2; ++b)
#pragma unroll
            for (int m = 0; m < 4; ++m)
#pragma unroll
                for (int n = 0; n < 2; ++n) acc[a][b][m][n] = (f32x4){0.f, 0.f, 0.f, 0.f};
    i32x8 At[4], B0[2], B1[2];
    const int sc_w = 0x79797979, sc_a = 0x7f7f7f7f; (void)sc_w; (void)sc_a;
    const char* cA = (const char*)g.A + (size_t)cur.pm * tstep + cur.koff; const char* cB = (const char*)g.Bt + (size_t)cur.pb * tstep + cur.koff;
    S.a_ready(cur);
    if constexpr (SP2) {
        PG8_STAGE(PG8_SB(0, 0), cB, voffB); PG8_STAGE(PG8_SB(0, 1), cB + hstep, voffB); PG8_STAGE(PG8_SA(0, 0), cA, voffA); PG8_STAGE(PG8_SA(0, 1), cA + hstep, voffA);
        if (wr == 1) PG8_BAR;
        PG8_WAIT_V(2); PG8_BAR;
        PG8_STAGE(PG8_SB(1, 0), cB + kstep, voffB); PG8_STAGE(PG8_SA(1, 0), cA + kstep, voffA); PG8_STAGE(PG8_SB(1, 1), cB + hstep + kstep, voffB);
        PG8_WAIT_V(6); PG8_BAR;
    } else {
        PG8_STAGE(PG8_SB(0, 0), cB, voffB); PG8_STAGE(PG8_SA(0, 0), cA, voffA); PG8_STAGE(PG8_SB(0, 1), cB + hstep, voffB); PG8_STAGE(PG8_SA(0, 1), cA + hstep, voffA);
        if (wr == 1) PG8_BAR;
        PG8_WAIT_V(4); PG8_BAR;
        PG8_STAGE(PG8_SB(1, 0), cB + kstep, voffB); PG8_STAGE(PG8_SA(1, 0), cA + kstep, voffA); PG8_STAGE(PG8_SB(1, 1), cB + hstep + kstep, voffB);
        PG8_WAIT_V(6); PG8_BAR;
    }
    for (;;) {
        const bool has_next = S.next(ui + 1, nxt);
        const char* nA = has_next ? (const char*)g.A + (size_t)nxt.pm * tstep + nxt.koff : cA; const char* nB = has_next ? (const char*)g.Bt + (size_t)nxt.pb * tstep + nxt.koff : cB;
        for (int t = 0; t < nt; t += 2) {
            const bool last = (t == nt - 2);
            const char* a1 = cA + (size_t)(t + 1) * kstep;
            const char* a2 = last ? nA : cA + (size_t)(t + 2) * kstep; const char* b2 = last ? nB : cB + (size_t)(t + 2) * kstep;
            const char* a3 = a2 + kstep; const char* b3 = b2 + kstep;
            if (last && has_next) S.a_ready(nxt);
            if constexpr (SP2) {
            PG8_LDB(B0, 0, 0); PG8_LDB(B1, 0, 1); PG8_SCHED; PG8_LDA(At, 0, 0); PG8_STAGE(PG8_SA(1, 1), a1 + hstep, voffA);
            PG8_WAIT_V(8); PG8_WAIT_L(0); PG8_BAR; PG8_MMA(0, 0, At, B0); PG8_MMA(0, 1, At, B1); PG8_BAR; PG8_SCHED;
            PG8_LDA(At, 0, 1); PG8_STAGE(PG8_SB(0, 0), b2, voffB); PG8_STAGE(PG8_SB(0, 1), b2 + hstep, voffB); PG8_STAGE(PG8_SA(0, 0), a2, voffA);
            PG8_WAIT_V(8); PG8_WAIT_L(0); PG8_BAR; PG8_MMA(1, 0, At, B0); PG8_MMA(1, 1, At, B1); PG8_BAR; PG8_SCHED;
            PG8_LDB(B0, 1, 0); PG8_LDB(B1, 1, 1); PG8_SCHED; PG8_LDA(At, 1, 0); PG8_STAGE(PG8_SA(0, 1), a2 + hstep, voffA);
            PG8_WAIT_V(8); PG8_WAIT_L(0); PG8_BAR; PG8_MMA(0, 0, At, B0); PG8_MMA(0, 1, At, B1); PG8_BAR; PG8_SCHED;
            PG8_LDA(At, 1, 1); PG8_STAGE(PG8_SB(1, 0), b3, voffB); PG8_STAGE(PG8_SB(1, 1), b3 + hstep, voffB); PG8_STAGE(PG8_SA(1, 0), a3, voffA);
            PG8_WAIT_V(8); PG8_WAIT_L(0); PG8_BAR; PG8_MMA(1, 0, At, B0); PG8_MMA(1, 1, At, B1); PG8_BAR; PG8_SCHED;
            } else {
            PG8_LDB(B0, 0, 0); PG8_SCHED; PG8_LDA(At, 0, 0); PG8_STAGE(PG8_SA(1, 1), a1 + hstep, voffA);
            PG8_WAIT_L(8); PG8_BAR; PG8_WAIT_L(0); PG8_MMA(0, 0, At, B0); PG8_BAR; PG8_SCHED;
            PG8_LDB(B1, 0, 1); PG8_STAGE(PG8_SB(0, 0), b2, voffB);
            PG8_BAR; PG8_WAIT_L(0); PG8_MMA(0, 1, At, B1); PG8_BAR;
            PG8_LDA(At, 0, 1); PG8_STAGE(PG8_SA(0, 0), a2, voffA);
            PG8_BAR; PG8_WAIT_L(0); PG8_MMA(1, 0, At, B0); PG8_BAR; PG8_SCHED;
            PG8_STAGE(PG8_SB(0, 1), b2 + hstep, voffB);
            PG8_WAIT_V(6); PG8_BAR; PG8_MMA(1, 1, At, B1); PG8_BAR;
            PG8_LDB(B0, 1, 0); PG8_SCHED; PG8_LDA(At, 1, 0); PG8_STAGE(PG8_SA(0, 1), a2 + hstep, voffA);
            PG8_WAIT_L(8); PG8_BAR; PG8_WAIT_L(0); PG8_MMA(0, 0, At, B0); PG8_BAR; PG8_SCHED;
            PG8_LDB(B1, 1, 1); PG8_STAGE(PG8_SB(1, 0), b3, voffB);
            PG8_BAR; PG8_WAIT_L(0); PG8_MMA(0, 1, At, B1); PG8_BAR;
            PG8_LDA(At, 1, 1); PG8_STAGE(PG8_SA(1, 0), a3, voffA);
            PG8_BAR; PG8_WAIT_L(0); PG8_MMA(1, 0, At, B0); PG8_BAR; PG8_SCHED;
            PG8_STAGE(PG8_SB(1, 1), b3 + hstep, voffB);
            PG8_WAIT_V(6); PG8_BAR; PG8_MMA(1, 1, At, B1); PG8_BAR;
            }
        }
        if constexpr (ALIGN_EPI) { if (wr == 0) PG8_BAR; }
        if constexpr (FP8) asm volatile("s_nop 15\n\ts_nop 15" ::: "memory");
        if constexpr (!Epi::AFTER_DRAIN) { E(acc, cur, wr, wc, fr, fq); S.done(cur); }
        if (!has_next) break;
#pragma unroll
        for (int a = 0; a < 2; ++a)
#pragma unroll
            for (int b = 0; b < 2; ++b)
#pragma unroll
                for (int m = 0; m < 4; ++m)
#pragma unroll
                    for (int n = 0; n < 2; ++n) acc[a][b][m][n] = (f32x4){0.f, 0.f, 0.f, 0.f};
        cur = nxt; cA = nA; cB = nB; ++ui;
        if constexpr (ALIGN_EPI) { if (wr == 1) PG8_BAR; }
    }
    PG8_WAIT_V(0);
    if constexpr (!ALIGN_EPI) { if (wr == 0) PG8_BAR; }
    PG8_BAR;
#undef PG8_SA
#undef PG8_SB
#undef PG8_STAGE
#undef PG8_LDA
#undef PG8_LDB
#undef PG8_K0
#undef PG8_K1
#undef PG8_MMA
#undef PG8_WAIT_V
#undef PG8_WAIT_L
#undef PG8_BAR
#undef PG8_SCHED
}
}

struct Params { const float* in[26]; float* out; unsigned char* ws; int ph_lo, ph_hi; };
enum { I_X = 0, I_C, I_CTX, I_CCTX, I_ADAW, I_ADAB, I_NMIX, I_NFFN, I_WIN, I_WOUT, I_DLAM, I_DNORM, I_RELB, I_HLB, I_HNORM, I_GW2, I_GB, I_GNORM,
       I_FW1, I_FW3, I_FW2, I_ROUTER, I_MW1, I_MW3, I_MW2, I_FNORM };

struct Frame { LAS unsigned char* lds; int tid, lane, wave, G, bid; };
typedef const __attribute__((address_space(4))) Params* KP;
__device__ __forceinline__ KP launder_kp(KP k) { asm volatile("" : "+s"(k)); return k; }
__device__ __forceinline__ Frame make_frame(LAS unsigned char* lds) {
    Frame F; F.lds = lds; int t = threadIdx.x; asm volatile("" : "+v"(t)); F.tid = t; F.lane = t & 63; F.wave = __builtin_amdgcn_readfirstlane(t >> 6); F.G = gridDim.x; F.bid = blockIdx.x; return F;
}

__device__ __forceinline__ int row_ci(int m) { return m < NLAT ? (m >> 11) : 4; }

struct CvDesc { const float* src; unsigned char* dst; int nsrc, pitch, out8; };
__device__ __forceinline__ CvDesc conv_desc(const float* W0, const float* W1, int K, int Nsrc, void* WT, int Ndst, int type, int item, int out8, int lane) {
    const int nblk = Ndst / 128, kb = item / nblk, nb = item % nblk, n0 = 128 * nb, k0 = 64 * kb;
    const float* W = W0; int sc = n0;
    if (type == 1) sc = n0 < Z_SRC ? n0 : n0 + 32;
    if (type == 2) { W = (nb & 1) ? W1 : W0; sc = 128 * (nb >> 1); }
    CvDesc d; d.src = W + (size_t)(k0 + 32 * (lane >> 5)) * Nsrc + sc + 4 * (lane & 31); d.nsrc = Nsrc; d.out8 = out8;
    d.pitch = out8 ? K : 2 * K; d.dst = (unsigned char*)WT + (size_t)n0 * d.pitch + (out8 ? k0 : 2 * k0);
    return d;
}
__device__ __forceinline__ void conv_ld16(const float* s, int nsrc, f32x4 (&r)[16]) {
#pragma unroll
    for (int kk = 0; kk < 16; ++kk) { r[kk] = __builtin_nontemporal_load((const f32x4*)s); s += nsrc; }
}
__device__ __forceinline__ void conv_put16(const CvDesc& d, LAS unsigned char* scr, int step, const f32x4 (&r)[16], int lane) {
    const int h = lane >> 5, c = lane & 31;
#pragma unroll
    for (int q = 0; q < 4; ++q) {
        const int rho = 32 * q + c;
        if (d.out8) { u32x4 w;
            w.x = cvt4_fp8(r[0][q] * W8_SCALE, r[1][q] * W8_SCALE, r[2][q] * W8_SCALE, r[3][q] * W8_SCALE);     w.y = cvt4_fp8(r[4][q] * W8_SCALE, r[5][q] * W8_SCALE, r[6][q] * W8_SCALE, r[7][q] * W8_SCALE);
            w.z = cvt4_fp8(r[8][q] * W8_SCALE, r[9][q] * W8_SCALE, r[10][q] * W8_SCALE, r[11][q] * W8_SCALE);   w.w = cvt4_fp8(r[12][q] * W8_SCALE, r[13][q] * W8_SCALE, r[14][q] * W8_SCALE, r[15][q] * W8_SCALE);
            *(LAS u32x4*)(scr + rho * 64 + (((2 * h + step) ^ ((rho >> 2) & 3)) * 16)) = w; }
        else { u32x4 w0, w1; const int p0 = 4 * h + 2 * step;
            w0.x = cvt_pk_bf16(r[0][q], r[1][q]); w0.y = cvt_pk_bf16(r[2][q], r[3][q]);   w0.z = cvt_pk_bf16(r[4][q], r[5][q]);   w0.w = cvt_pk_bf16(r[6][q], r[7][q]);
            w1.x = cvt_pk_bf16(r[8][q], r[9][q]); w1.y = cvt_pk_bf16(r[10][q], r[11][q]); w1.z = cvt_pk_bf16(r[12][q], r[13][q]); w1.w = cvt_pk_bf16(r[14][q], r[15][q]);
            *(LAS u32x4*)(scr + rho * 128 + ((p0 ^ (rho & 7)) * 16)) = w0; *(LAS u32x4*)(scr + rho * 128 + (((p0 + 1) ^ (rho & 7)) * 16)) = w1; }
    }
}
__device__ __forceinline__ void conv_flush(const CvDesc& d, const LAS unsigned char* scr, int lane) {
    if (d.out8) { const int j = lane & 3;
#pragma unroll
        for (int t = 0; t < 8; ++t) { const int rho = (lane >> 2) + 16 * t, n = 4 * (rho & 31) + (rho >> 5);
            const u32x4 w = *(const LAS u32x4*)(scr + rho * 64 + ((j ^ ((rho >> 2) & 3)) * 16));
            __builtin_nontemporal_store(w, (u32x4*)(d.dst + (size_t)n * d.pitch + 16 * j)); } }
    else { const int j = lane & 7;
#pragma unroll
        for (int t = 0; t < 16; ++t) { const int rho = (lane >> 3) + 8 * t, n = 4 * (rho & 31) + (rho >> 5);
            const u32x4 w = *(const LAS u32x4*)(scr + rho * 128 + ((j ^ (rho & 7)) * 16));
            __builtin_nontemporal_store(w, (u32x4*)(d.dst + (size_t)n * d.pitch + 16 * j)); } }
}
template <class DescFn>
__device__ __forceinline__ void conv_items(DescFn desc, int first, int stride, int n, LAS unsigned char* scr, int lane) {
    CvDesc d = desc(first);
    f32x4 ra[16], rb[16];
    conv_ld16(d.src, d.nsrc, ra);
    for (int t = 0; t < n; ++t) {
        const bool has = t + 1 < n;
        CvDesc nd = d; if (has) nd = desc(first + stride * (t + 1));
        conv_ld16(d.src + (size_t)16 * d.nsrc, d.nsrc, rb);
        conv_put16(d, scr, 0, ra, lane);
        if (has) conv_ld16(nd.src, nd.nsrc, ra);
        conv_put16(d, scr, 1, rb, lane);
        conv_flush(d, scr, lane);
        d = nd;
    }
}
template <int BATCH, class DescFn>
__device__ __forceinline__ void conv_queue(const Frame& F, unsigned* ctr, int limit, int total, DescFn desc) {
    volatile LAS int* slot = (volatile LAS int*)(F.lds + MISC_OFF + 128);
    __syncthreads();
    for (;;) {
        if (F.tid == 0) {
            int st = -1;
            if (__hip_atomic_load(ctr, __ATOMIC_RELAXED, __HIP_MEMORY_SCOPE_AGENT) < (unsigned)limit) st = (int)__hip_atomic_fetch_add(ctr, (unsigned)BATCH, __ATOMIC_RELAXED, __HIP_MEMORY_SCOPE_AGENT);
            *slot = st;
        }
        __syncthreads();
        const int start = *slot;
        if (start < 0 || start >= total) break;
        conv_items(desc, start + F.wave, NWAVES, BATCH / NWAVES, F.lds + F.wave * 16384, F.lane);
        __syncthreads();
    }
    __syncthreads();
}

constexpr int CV_IN = (D / 64) * (NPI / 128), CV_OUT = (D / 64) * (D / 128), CV_13 = (D / 64) * (2 * FFD / 128), CV_2 = (FFD / 64) * (D / 128),
              CV_13E = (D / 64) * (2 * FFE / 128), CV_2E = (FFE / 64) * (D / 128);
constexpr int CV_P0_ITEMS = CV_IN + CV_OUT + CV_13 + CV_2;
constexpr int CV_L1_ITEMS = CV_IN + CV_OUT;
constexpr int CV_DEF_ITEMS = CV_L1_ITEMS + NEXP * CV_13E + NEXP * CV_2E;
constexpr int FFU_GEMM_WGS = 176, CV_FFU_ITEMS = NEXP * CV_13E;
__device__ __forceinline__ CvDesc conv_p0_desc(KP p, int it, int lane) {
    unsigned char* ws = p->ws; int r = it;
    if (r < CV_IN) return conv_desc(p->in[I_WIN], nullptr, D, INW, ws + WS_WIN, NPI, 1, r, 0, lane);
    r -= CV_IN;
    if (r < CV_OUT) return conv_desc(p->in[I_WOUT], nullptr, D, D, ws + WS_WOUT, D, 0, r, 0, lane);
    r -= CV_OUT;
    if (r < CV_13) return conv_desc(p->in[I_FW1], p->in[I_FW3], D, FFD, ws + WS_W13, 2 * FFD, 2, r, (FFU_FP8) ? 1 : 0, lane);
    r -= CV_13;
    return conv_desc(p->in[I_FW2], nullptr, FFD, D, ws + WS_W2, D, 0, r, 1, lane);
}
__device__ __forceinline__ CvDesc conv_def_desc(KP p, int it, int lane) {
    unsigned char* ws = p->ws; int r = it;
    if (r < CV_IN) return conv_desc(p->in[I_WIN] + (size_t)D * INW, nullptr, D, INW, (bf16*)(ws + WS_WIN) + (size_t)NPI * D, NPI, 1, r, 0, lane);
    r -= CV_IN;
    if (r < CV_OUT) return conv_desc(p->in[I_WOUT] + (size_t)D * D, nullptr, D, D, (bf16*)(ws + WS_WOUT) + (size_t)D * D, D, 0, r, 0, lane);
    r -= CV_OUT;
    if (r < NEXP * CV_13E) { const int e = r / CV_13E; r -= e * CV_13E;
        return conv_desc(p->in[I_MW1] + (size_t)e * D * FFE, p->in[I_MW3] + (size_t)e * D * FFE, D, FFE, ws + WS_W13E + (size_t)e * 2 * FFE * D, 2 * FFE, 2, r, 1, lane); }
    r -= NEXP * CV_13E;
    { const int e = r / CV_2E; r -= e * CV_2E;
        return conv_desc(p->in[I_MW2] + (size_t)e * FFE * D, nullptr, FFE, D, ws + WS_W2E + (size_t)e * D * FFE, D, 0, r, 1, lane); }
}
__device__ __forceinline__ void conv_drain(KP p, const Frame& F, int limit) {
    const int lane = F.lane;
    conv_queue<16>(F, (unsigned*)(p->ws + WS_CTL) + CW_CONV, limit, CV_DEF_ITEMS, [&](int it) { return conv_def_desc(p, it, lane); });
}
__device__ __forceinline__ void p0_prologue(KP p, const Frame& F) {
    unsigned char* ws = p->ws;
    {
        LAS float* cond = (LAS float*)F.lds;
        LAS float* red = (LAS float*)(F.lds + 65536);
        for (int k = F.tid; k < D; k += NTHR) {
#pragma unroll
            for (int ci = 0; ci < 4; ++ci) cond[k * 8 + ci] = fsilu(p->in[I_C][ci * D + k]);
            cond[k * 8 + 4] = fsilu(p->in[I_CCTX][k]); cond[k * 8 + 5] = 0.f; cond[k * 8 + 6] = 0.f; cond[k * 8 + 7] = 0.f;
        }
        __syncthreads();
        float* MOD = (float*)(ws + WS_MOD);
        constexpr int AC = 48;
        for (int it = F.bid; it < 2 * (MODW / AC); it += F.G) {
            const int l = it / (MODW / AC), n0 = (it % (MODW / AC)) * AC;
            const bool act = F.lane < AC;
            const float* w = p->in[I_ADAW] + (size_t)l * D * MODW + n0 + (act ? F.lane : 0);
            float a0 = 0.f, a1 = 0.f, a2 = 0.f, a3 = 0.f, a4 = 0.f;
            const int kb = F.wave * 256;
            for (int k0 = kb; k0 < kb + 256; k0 += 16) {
                float wv[16];
#pragma unroll
                for (int u = 0; u < 16; ++u) wv[u] = w[(size_t)(k0 + u) * MODW];
#pragma unroll
                for (int u = 0; u < 16; ++u) { const f32x4 c4 = *(const LAS f32x4*)(cond + (k0 + u) * 8); const float c5 = cond[(k0 + u) * 8 + 4];
                    a0 += c4[0] * wv[u]; a1 += c4[1] * wv[u]; a2 += c4[2] * wv[u]; a3 += c4[3] * wv[u]; a4 += c5 * wv[u]; }
            }
            red[(F.wave * 5 + 0) * 64 + F.lane] = a0; red[(F.wave * 5 + 1) * 64 + F.lane] = a1; red[(F.wave * 5 + 2) * 64 + F.lane] = a2;
            red[(F.wave * 5 + 3) * 64 + F.lane] = a3; red[(F.wave * 5 + 4) * 64 + F.lane] = a4;
            __syncthreads();
            if (F.tid < 320) { const int ci = F.tid / 64, ln = F.tid % 64;
                if (ln < AC) { float s = p->in[I_ADAB][(size_t)l * MODW + n0 + ln];
#pragma unroll
                    for (int w8 = 0; w8 < 8; ++w8) s += red[(w8 * 5 + ci) * 64 + ln];
                    MOD[((size_t)l * 5 + ci) * MODW + n0 + ln] = s; } }
            __syncthreads();
        }
    }
    __syncthreads();
    {
        bf16* WZT = (bf16*)(ws + WS_WZT);
        for (int i = F.bid * NTHR + F.tid; i < 2 * 32 * D; i += F.G * NTHR) { const int l = i / (32 * D), r = i % (32 * D), zc = r / D, k = r % D;
            WZT[i] = (bf16)(cvt_pk_bf16(p->in[I_WIN][((size_t)l * D + k) * INW + Z_SRC + zc], 0.f) & 0xffffu); }
    }
    { const int lane = F.lane;
      conv_queue<8>(F, (unsigned*)(ws + WS_CTL) + CW_CONV0, CV_P0_ITEMS, CV_P0_ITEMS, [&](int it) { return conv_p0_desc(p, it, lane); }); }
}

template <bool ROUTE, bool OUT8 = false, int CTXP = 0>
__device__ __forceinline__ void norm_phase(KP p, const Frame& F, int l, bool first_layer_src, const float* gain, int shift_chunk, int scale_chunk, int nrows) {
    unsigned char* ws = p->ws;
    const float* MOD = (const float*)(ws + WS_MOD) + (size_t)l * 5 * MODW;
    const float* X = (const float*)(ws + WS_X);
    bf16* H = (bf16*)(ws + WS_H);
    const int gw = F.bid * NWAVES + F.wave, NGW = F.G * NWAVES;
    volatile LAS unsigned* rcnt = (volatile LAS unsigned*)(F.lds + MISC_OFF + 512);
    if constexpr (ROUTE) {
        if (F.tid < 8) rcnt[F.tid] = 0u;
        const f32x4* rsrc = (const f32x4*)p->in[I_ROUTER]; LAS f32x4* rdst = (LAS f32x4*)F.lds;
        for (int i = F.tid; i < D * 8 / 4; i += NTHR) rdst[i] = rsrc[i];
        __syncthreads(); }
    for (int m = gw; m < nrows; m += NGW) {
        const float* src = first_layer_src ? (m < NLAT ? p->in[I_X] + (size_t)m * D : p->in[I_CTX] + (size_t)(m - NLAT) * D) : X + (size_t)m * D;
        const int ci = row_ci(m);
        const f32x4* xr = (const f32x4*)src + F.lane;
        f32x4 v[8]; float ss = 0.f;
#pragma unroll
        for (int j = 0; j < 8; ++j) v[j] = xr[64 * j];
        if (CTXP == 1 && m >= NLAT) {
            const f32x4* gq = (const f32x4*)((const float*)(ws + WS_MOD) + (size_t)(l - 1) * 5 * MODW + (size_t)4 * MODW + 5 * D) + F.lane;
            const f32x4* pp = (const f32x4*)((const float*)(ws + WS_SPLIT) + (size_t)(m - NLAT) * D) + F.lane;
#pragma unroll
            for (int j = 0; j < 8; ++j) { f32x4 a = pp[64 * j];
#pragma unroll
                for (int ks = 1; ks < FFD_KS; ++ks) a = a + pp[(size_t)ks * NCTX * D / 4 + 64 * j];
                v[j] = v[j] + gq[64 * j] * a; }
        }
        if (CTXP == 2 && m >= NLAT) {
            const f32x4* cin = (const f32x4*)(p->in[I_CTX] + (size_t)(m - NLAT) * D) + F.lane;
            const f32x4* gq = (const f32x4*)((const float*)(ws + WS_MOD) + (size_t)l * 5 * MODW + (size_t)4 * MODW + 2 * D) + F.lane;
            const f32x4* pp = (const f32x4*)((const float*)(ws + WS_SPLIT) + (size_t)(m - NLAT) * D) + F.lane;
            f32x4* xo = (f32x4*)((float*)(ws + WS_X) + (size_t)m * D) + F.lane;
#pragma unroll
            for (int j = 0; j < 8; ++j) { f32x4 a = pp[64 * j];
#pragma unroll
                for (int ks = 1; ks < OUT_KS; ++ks) a = a + pp[(size_t)ks * NCTX * D / 4 + 64 * j];
                v[j] = cin[64 * j] + gq[64 * j] * a; xo[64 * j] = v[j]; }
        }
#pragma unroll
        for (int j = 0; j < 8; ++j) ss += (v[j][0] * v[j][0] + v[j][1] * v[j][1]) + (v[j][2] * v[j][2] + v[j][3] * v[j][3]);
        const float rstd = 1.0f / sqrtf(wave_sum(ss) * (1.0f / D) + NORM_EPS);
        const f32x4* gp = (const f32x4*)gain + F.lane;
        const f32x4* shp = (const f32x4*)(MOD + (size_t)ci * MODW + shift_chunk * D) + F.lane;
        const f32x4* scp = (const f32x4*)(MOD + (size_t)ci * MODW + scale_chunk * D) + F.lane;
        u32x2* o8 = (u32x2*)(H + (size_t)m * D) + F.lane;
        unsigned* o4 = (unsigned*)((unsigned char*)H + (size_t)m * D) + F.lane;
#pragma unroll
        for (int j = 0; j < 8; ++j) { const f32x4 gg = gp[64 * j], sh = shp[64 * j], sc = scp[64 * j];
            v[j] = v[j] * rstd * gg * (sc + 1.0f) + sh;
            if (OUT8) o4[64 * j] = cvt4_fp8(v[j][0], v[j][1], v[j][2], v[j][3]);
            else { u32x2 w; w.x = cvt_pk_bf16(v[j][0], v[j][1]); w.y = cvt_pk_bf16(v[j][2], v[j][3]); o8[64 * j] = w; } }
        if constexpr (ROUTE) {
            const LAS float* rw = (const LAS float*)F.lds;
            float lg[8];
#pragma unroll
            for (int e = 0; e < 8; ++e) lg[e] = 0.f;
#pragma unroll
            for (int j = 0; j < 8; ++j)
#pragma unroll
                for (int q = 0; q < 4; ++q) { const int c = 256 * j + 4 * F.lane + q; const f32x4 r0 = *(const LAS f32x4*)(rw + c * 8), r1 = *(const LAS f32x4*)(rw + c * 8 + 4); const float y = v[j][q];
                    lg[0] += y * r0[0]; lg[1] += y * r0[1]; lg[2] += y * r0[2]; lg[3] += y * r0[3]; lg[4] += y * r1[0]; lg[5] += y * r1[1]; lg[6] += y * r1[2]; lg[7] += y * r1[3]; }
#pragma unroll
            for (int e = 0; e < 8; ++e) lg[e] = wave_sum(lg[e]);
            if (F.lane == 0) {
                int i0 = 0; float v0 = lg[0];
#pragma unroll
                for (int e = 1; e < 8; ++e) if (lg[e] > v0) { v0 = lg[e]; i0 = e; }
                int i1 = -1; float v1 = -3.0e38f;
#pragma unroll
                for (int e = 0; e < 8; ++e) if (e != i0 && lg[e] > v1) { v1 = lg[e]; i1 = e; }
                const float w0 = 1.0f / (1.0f + __expf(v1 - v0)), w1 = 1.0f - w0;
                unsigned* rt = (unsigned*)(ws + WS_ROUTE) + (size_t)m * 4;
                rt[0] = (unsigned)i0; rt[1] = (unsigned)i1; rt[2] = __float_as_uint(w0); rt[3] = __float_as_uint(w1);
                __hip_atomic_fetch_add((LAS unsigned*)(rcnt + i0), 1u, __ATOMIC_RELAXED, __HIP_MEMORY_SCOPE_WORKGROUP);
                __hip_atomic_fetch_add((LAS unsigned*)(rcnt + i1), 1u, __ATOMIC_RELAXED, __HIP_MEMORY_SCOPE_WORKGROUP);
            }
        }
    }
    if constexpr (ROUTE) { __syncthreads(); if (F.tid < 8) ((unsigned*)(ws + WS_BCNT))[(size_t)F.bid * 8 + F.tid] = rcnt[F.tid]; }
}

__device__ __forceinline__ void prep_phase(KP p, const Frame& F, int l, bool ctx_out, int parts = 15, size_t wofs = 0  ) {
    unsigned char* ws = p->ws;
    bf16* P = (bf16*)(ws + WS_P);
    const int gw = F.bid * NWAVES + F.wave, NGW = F.G * NWAVES;
    const int lane = F.lane;
    if (parts & 1) {
        const float qs = 0.17677669529663687f * LOG2E;
        float* kna = (float*)(ws + WS_KNA); float* knb = (float*)(ws + WS_KNB);
        for (int m = gw; m < MT; m += NGW) {
            bf16* row = P + (size_t)m * NPI; bf16* wrow = row + wofs;
            const int b = m < NLAT ? (m >> 11) : ((m - NLAT) >> 8);
            const int key = m < NLAT ? (CTXL + (m & (SEQ - 1))) : ((m - NLAT) & (CTXL - 1));
            if (m < NLAT) {
                const int t = m & (SEQ - 1), i = lane & 15;
                const float pos = (i < 8) ? (float)(t >> 6) : (float)(t & 63);
                const float inv = exp2f(-(float)(i & 7) * (13.287712379549449f / 8.0f));
                float sn, cs; sincosf(pos * inv, &sn, &cs);
#pragma unroll
                for (int c = 0; c < 8; ++c) {
                    const int combo = (lane >> 4) + 4 * c;
                    const int base = (combo >> 4) * 512 + (combo & 15) * 32;
                    const float x1 = bf2f(row[base + i]), x2 = bf2f(row[base + 16 + i]);
                    float y1 = x1 * cs - x2 * sn, y2 = x1 * sn + x2 * cs;
                    if (combo < 16) { y1 *= qs; y2 *= qs; }
                    const unsigned w = cvt_pk_bf16(y1, y2);
                    wrow[base + i] = (bf16)(w & 0xffffu); wrow[base + 16 + i] = (bf16)(w >> 16);
                    if (c >= 4) { float n2 = y1 * y1 + y2 * y2; n2 += __shfl_xor(n2, 1); n2 += __shfl_xor(n2, 2); n2 += __shfl_xor(n2, 4); n2 += __shfl_xor(n2, 8);
                        if (i == 0) kna[((size_t)b * 16 + (combo & 15)) * KEYS + key] = n2; }
                }
            } else {
#pragma unroll
                for (int c = 0; c < 8; ++c) { const int idx = lane + 64 * c;
                    if (ctx_out) { const unsigned w = cvt_pk_bf16(bf2f(row[idx]) * qs, 0.f); wrow[idx] = (bf16)(w & 0xffffu); }
                    const float kv = bf2f(row[512 + idx]); float n2 = kv * kv;
                    n2 += __shfl_xor(n2, 1); n2 += __shfl_xor(n2, 2); n2 += __shfl_xor(n2, 4); n2 += __shfl_xor(n2, 8); n2 += __shfl_xor(n2, 16);
                    if ((lane & 31) == 0) kna[((size_t)b * 16 + 2 * c + (lane >> 5)) * KEYS + key] = n2; }
            }
            { const u32x4 w = *(const u32x4*)(row + B_K + 8 * lane);
              float n2 = (bflo(w.x) * bflo(w.x) + bfhi(w.x) * bfhi(w.x)) + (bflo(w.y) * bflo(w.y) + bfhi(w.y) * bfhi(w.y)) + (bflo(w.z) * bflo(w.z) + bfhi(w.z) * bfhi(w.z)) + (bflo(w.w) * bflo(w.w) + bfhi(w.w) * bfhi(w.w));
              n2 += __shfl_xor(n2, 1); n2 += __shfl_xor(n2, 2); n2 += __shfl_xor(n2, 4);
              if ((lane & 7) == 0) knb[((size_t)b * 8 + (lane >> 3)) * KEYS + key] = n2; }
        }
    }
    if (parts & 2) {
        const int nitems = 2 * NB * 8 * (KEYS / 64);
        for (int it = gw; it < nitems; it += NGW) {
            const int mix = it / (NB * 8 * (KEYS / 64)); int r = it % (NB * 8 * (KEYS / 64));
            const int b = r / (8 * (KEYS / 64)); r %= 8 * (KEYS / 64); const int h = r / (KEYS / 64), kc = r % (KEYS / 64);
            const int key = kc * 64 + lane;
            const size_t srow = key < CTXL ? (size_t)(NLAT + b * CTXL + key) : (size_t)(b * SEQ + key - CTXL);
            const u32x4* src = (const u32x4*)(P + srow * NPI + (mix ? B_V : A_V) + h * 64);
            bf16* dst = (bf16*)(ws + (mix ? WS_VTB : WS_VTA)) + ((size_t)(b * 8 + h) * 64) * KEYS + key;
#pragma unroll
            for (int q = 0; q < 8; ++q) { const u32x4 w = src[q];
                dst[(size_t)(8 * q + 0) * KEYS] = (bf16)(w.x & 0xffffu); dst[(size_t)(8 * q + 1) * KEYS] = (bf16)(w.x >> 16);
                dst[(size_t)(8 * q + 2) * KEYS] = (bf16)(w.y & 0xffffu); dst[(size_t)(8 * q + 3) * KEYS] = (bf16)(w.y >> 16);
                dst[(size_t)(8 * q + 4) * KEYS] = (bf16)(w.z & 0xffffu); dst[(size_t)(8 * q + 5) * KEYS] = (bf16)(w.z >> 16);
                dst[(size_t)(8 * q + 6) * KEYS] = (bf16)(w.w & 0xffffu); dst[(size_t)(8 * q + 7) * KEYS] = (bf16)(w.w >> 16); }
        }
    }
    if (parts & 4) {
        float* HLA = (float*)(ws + WS_HLA);
        const int c0 = 8 * lane;
        float lbv[2][8];
#pragma unroll
        for (int dir = 0; dir < 2; ++dir)
#pragma unroll
            for (int j = 0; j < 8; ++j) { float lb = 0.f;
                if (l > 0) { const float h0 = p->in[I_HLB][((size_t)dir * 2 + 0) * 512 + c0 + j], h1 = p->in[I_HLB][((size_t)dir * 2 + 1) * 512 + c0 + j]; lb = fminf(fmaxf(1.0f / (1.0f + __expf(h0 - h1)), 0.f), 1.0f - 1e-6f); }
                lbv[dir][j] = lb; }
        auto gates = [&](bf16* wrow, int m, u32x4 wq, u32x4 wf0, u32x4 wf1) {
            { float x[8] = {bflo(wq.x), bfhi(wq.x), bflo(wq.y), bfhi(wq.y), bflo(wq.z), bfhi(wq.z), bflo(wq.w), bfhi(wq.w)};
#pragma unroll
              for (int j = 0; j < 8; ++j) x[j] = fsilu(x[j]);
              u32x4 w; w.x = cvt_pk_bf16(x[0], x[1]); w.y = cvt_pk_bf16(x[2], x[3]); w.z = cvt_pk_bf16(x[4], x[5]); w.w = cvt_pk_bf16(x[6], x[7]); *(u32x4*)(wrow + C_Q + c0) = w; }
#pragma unroll
            for (int dir = 0; dir < 2; ++dir) {
                const int fcol = (dir ? C_FB : C_FF) + c0;
                u32x4 w = dir ? wf1 : wf0; float x[8] = {bflo(w.x), bfhi(w.x), bflo(w.y), bfhi(w.y), bflo(w.z), bfhi(w.z), bflo(w.w), bfhi(w.w)};
                float la[8], kk[8];
#pragma unroll
                for (int j = 0; j < 8; ++j) {
                    const float lb = lbv[dir][j];
                    const float sg = fsigmoid(x[j]); const float a = lb + (1.0f - lb) * sg;
                    la[j] = fmaxf(__logf(a), -60.0f); kk[j] = (1.0f - lb) * (1.0f - sg);
                }
                w.x = cvt_pk_bf16(kk[0], kk[1]); w.y = cvt_pk_bf16(kk[2], kk[3]); w.z = cvt_pk_bf16(kk[4], kk[5]); w.w = cvt_pk_bf16(kk[6], kk[7]); *(u32x4*)(wrow + fcol) = w;
                float* hp = HLA + ((size_t)dir * MT + m) * 512 + c0;
                *(f32x4*)hp = (f32x4){la[0], la[1], la[2], la[3]}; *(f32x4*)(hp + 4) = (f32x4){la[4], la[5], la[6], la[7]};
            } };
        for (int m = gw; m < MT; m += 2 * NGW) {
            const int mb = m + NGW; const bool hasb = mb < MT;
            bf16* rowa = P + (size_t)m * NPI; bf16* rowb = P + (size_t)(hasb ? mb : m) * NPI;
            const u32x4 qa = *(const u32x4*)(rowa + C_Q + c0), fa0 = *(const u32x4*)(rowa + C_FF + c0), fa1 = *(const u32x4*)(rowa + C_FB + c0);
            const u32x4 qb = *(const u32x4*)(rowb + C_Q + c0), fb0 = *(const u32x4*)(rowb + C_FF + c0), fb1 = *(const u32x4*)(rowb + C_FB + c0);
            gates(rowa + wofs, m, qa, fa0, fa1);
            if (hasb) gates(rowb + wofs, mb, qb, fb0, fb1);
        }
    }
    if (parts & 8) {
        const bf16* H = (const bf16*)(ws + WS_H);
        const bf16* WZT = (const bf16*)(ws + WS_WZT) + (size_t)l * 32 * D;
        const int fr = lane & 15, g = lane >> 4;
        const int nit = (MT / 16 - F.bid + F.G - 1) / F.G;
        LAS float* part = (LAS float*)F.lds;
        LAS float* zfin = (LAS float*)(F.lds + 3 * 16384);
        for (int j = 0; j < nit; ++j) {
            const int row0 = (F.bid + j * F.G) * 16;
            f32x4 a0 = {0.f, 0.f, 0.f, 0.f}, a1 = {0.f, 0.f, 0.f, 0.f};
            const bf16* hp = H + (size_t)(row0 + fr) * D + 8 * g + F.wave * 256; const bf16* w0 = WZT + (size_t)fr * D + 8 * g + F.wave * 256; const bf16* w1 = WZT + (size_t)(16 + fr) * D + 8 * g + F.wave * 256;
#pragma unroll
            for (int ks = 0; ks < 8; ++ks) {
                const bf16x8 av = *(const bf16x8*)(hp + ks * 32), b0 = *(const bf16x8*)(w0 + ks * 32), b1 = *(const bf16x8*)(w1 + ks * 32);
                a0 = __builtin_amdgcn_mfma_f32_16x16x32_bf16(av, b0, a0, 0, 0, 0);
                a1 = __builtin_amdgcn_mfma_f32_16x16x32_bf16(av, b1, a1, 0, 0, 0);
            }
            LAS float* zt = part + (j * 8 + F.wave) * 512;
#pragma unroll
            for (int r = 0; r < 4; ++r) { zt[(4 * g + r) * 32 + fr] = a0[r]; zt[(4 * g + r) * 32 + 16 + fr] = a1[r]; }
        }
        __syncthreads();
        for (int j = 0; j < nit; ++j) { float sacc = 0.f;
#pragma unroll
            for (int w = 0; w < 8; ++w) sacc += part[(j * 8 + w) * 512 + F.tid];
            zfin[j * 512 + F.tid] = sacc; }
        __syncthreads();
        float* LG = (float*)(ws + WS_LG);
        { const int e = F.wave, dir = e >> 2, c = lane + 64 * (e & 3);
          const float* w2 = p->in[I_GW2] + ((size_t)(l * 2 + dir) * 16) * 256 + c;
          float wv[16];
#pragma unroll
          for (int r = 0; r < 16; ++r) wv[r] = w2[(size_t)r * 256];
          const float bias = p->in[I_GB][(size_t)(l * 2 + dir) * 256 + c];
          for (int j = 0; j < nit; ++j) {
            const int row0 = (F.bid + j * F.G) * 16; const LAS float* zt = zfin + j * 512;
#pragma unroll 4
            for (int rr = 0; rr < 16; ++rr) {
                const LAS f32x4* zr = (const LAS f32x4*)(zt + rr * 32 + dir * 16);
                const f32x4 z0 = zr[0], z1 = zr[1], z2 = zr[2], z3 = zr[3];
                float pre = bias;
#pragma unroll
                for (int q = 0; q < 4; ++q) pre += z0[q] * wv[q] + z1[q] * wv[4 + q] + z2[q] * wv[8 + q] + z3[q] * wv[12 + q];
                const float lsg = fminf(pre, 0.f) - __logf(1.0f + __expf(-fabsf(pre)));
                LG[((size_t)dir * MT + row0 + rr) * 256 + c] = lsg * (1.0f / 16.0f);
            } } }
        __syncthreads();
    }
}

constexpr int KV_PITCH = 144, KV_BUF = 64 * KV_PITCH;
__device__ __forceinline__ void kv_load(const bf16* P, const bf16* VT, int kcol, size_t krow0, int vkey0, int tid, u32x4& kr, u32x4& vr) {
    const int row = tid >> 3, ch = tid & 7;
    kr = *(const u32x4*)(P + (krow0 + row) * NPI + kcol + ch * 8);
    vr = *(const u32x4*)(VT + (size_t)row * KEYS + vkey0 + ch * 8);
}
__device__ __forceinline__ void kv_store(LAS unsigned char* kb, LAS unsigned char* vb, int tid, const u32x4& kr, const u32x4& vr) {
    const int row = tid >> 3, ch = tid & 7;
    *(LAS u32x4*)(kb + row * KV_PITCH + ch * 16) = kr; *(LAS u32x4*)(vb + row * KV_PITCH + ch * 16) = vr;
}
__device__ __forceinline__ bf16x8 v_frag(const LAS unsigned char* vb, int d, int ko, int fr, int g) {
    const LAS unsigned char* a = vb + (d * 16 + fr) * KV_PITCH + (ko + 4 * g) * 2;
    const u32x2 lo = *(const LAS u32x2*)a, hi = *(const LAS u32x2*)(a + 32);
    u32x4 w; w.x = lo.x; w.y = lo.y; w.z = hi.x; w.w = hi.y; return __builtin_bit_cast(bf16x8, w);
}

__device__ __forceinline__ float block_max(const float* v, int n, const Frame& F, volatile LAS float* red) {
    float mxv = 0.f;
    for (int i = F.tid; i < n; i += NTHR) mxv = fmaxf(mxv, v[i]);
#pragma unroll
    for (int o = 1; o < 64; o <<= 1) mxv = fmaxf(mxv, __shfl_xor(mxv, o));
    __syncthreads();
    if (F.lane == 0) red[F.wave] = mxv;
    __syncthreads();
    float r = red[0];
#pragma unroll
    for (int w8 = 1; w8 < 8; ++w8) r = fmaxf(r, red[w8]);
    return r;
}
__device__ __forceinline__ void diffattn_block(const bf16* P, const bf16* VTA, bf16* MIX, const Frame& F, int b, int h, int qrow_blk, int ntiles, float lam, float oscale, const float* normg, const float* kn  , int nkeys) {
    const int lane = F.lane, fr = lane & 15, g = lane >> 4, tid = F.tid;
    const int q0row = qrow_blk + 32 * F.wave;
    LAS unsigned char* lds = F.lds;
    bf16x8 qf[2][2];
#pragma unroll
    for (int m = 0; m < 2; ++m)
#pragma unroll
        for (int qt = 0; qt < 2; ++qt) qf[m][qt] = *(const bf16x8*)(P + (size_t)(q0row + qt * 16 + fr) * NPI + A_Q + h * 64 + m * 32 + 8 * g);
    volatile LAS float* red = (volatile LAS float*)(lds + MISC_OFF + 192);
    float kmax2[2];
#pragma unroll
    for (int m = 0; m < 2; ++m) kmax2[m] = block_max(kn + (size_t)(2 * h + m) * KEYS, nkeys, F, red);
    f32x4 O[2][2][4]; float mx[2][2], ls[2][2];
#pragma unroll
    for (int m = 0; m < 2; ++m)
#pragma unroll
        for (int qt = 0; qt < 2; ++qt) { ls[m][qt] = 0.f;
            float qn2 = 0.f;
#pragma unroll
            for (int j = 0; j < 8; ++j) { const float qv = bf2f((bf16)qf[m][qt][j]); qn2 += qv * qv; }
            qn2 = xsum32(xsum16(qn2));
            mx[m][qt] = sqrtf(qn2 * kmax2[m]);
#pragma unroll
            for (int d = 0; d < 4; ++d) O[m][qt][d] = (f32x4){0.f, 0.f, 0.f, 0.f}; }
    const bf16* vt = VTA + ((size_t)(b * 8 + h) * 64) * KEYS;
    const f32x4 zero = {0.f, 0.f, 0.f, 0.f};
    u32x4 kreg, vreg;
#define DA_TILE_LOAD(t) do { const int key0_ = (t) * 64; const size_t krow0_ = key0_ < CTXL ? (size_t)(NLAT + b * CTXL + key0_) : (size_t)(b * SEQ + key0_ - CTXL); \
        kv_load(P, vt, A_K + h * 64, krow0_, key0_, tid, kreg, vreg); } while (0)
    DA_TILE_LOAD(0);
    for (int t = 0; t < ntiles; ++t) {
        LAS unsigned char* kb = lds + (t & 1) * 2 * KV_BUF; LAS unsigned char* vb = kb + KV_BUF;
        kv_store(kb, vb, tid, kreg, vreg);
        __syncthreads();
        if (t + 1 < ntiles) DA_TILE_LOAD(t + 1);
#pragma unroll
        for (int st = 0; st < 2; ++st) {
            const int ko = 32 * st;
            bf16x8 kf[2][2], vf[4];
#pragma unroll
            for (int m = 0; m < 2; ++m)
#pragma unroll
                for (int kt = 0; kt < 2; ++kt) kf[m][kt] = *(const LAS bf16x8*)(kb + (ko + kt * 16 + fr) * KV_PITCH + (m * 32 + 8 * g) * 2);
#pragma unroll
            for (int d = 0; d < 4; ++d) vf[d] = v_frag(vb, d, ko, fr, g);
            bf16x8 pb[2][2];
#pragma unroll
            for (int m = 0; m < 2; ++m) {
                f32x4 sc[2][2];
#pragma unroll
                for (int qt = 0; qt < 2; ++qt) { const float nb = -mx[m][qt]; const f32x4 c0 = {nb, nb, nb, nb};
#pragma unroll
                    for (int kt = 0; kt < 2; ++kt) sc[qt][kt] = __builtin_amdgcn_mfma_f32_16x16x32_bf16(kf[m][kt], qf[m][qt], c0, 0, 0, 0); }
                __builtin_amdgcn_sched_barrier(0);
#pragma unroll
                for (int qt = 0; qt < 2; ++qt) {
                    const f32x4 s0 = sc[qt][0], s1 = sc[qt][1];
                    const float p0 = fexp2(s0[0]), p1 = fexp2(s0[1]), p2 = fexp2(s0[2]), p3 = fexp2(s0[3]);
                    const float p4 = fexp2(s1[0]), p5 = fexp2(s1[1]), p6 = fexp2(s1[2]), p7 = fexp2(s1[3]);
                    ls[m][qt] += ((p0 + p1) + (p2 + p3)) + ((p4 + p5) + (p6 + p7));
                    u32x4 pw; pw.x = cvt_pk_bf16(p0, p1); pw.y = cvt_pk_bf16(p2, p3); pw.z = cvt_pk_bf16(p4, p5); pw.w = cvt_pk_bf16(p6, p7);
                    pb[m][qt] = __builtin_bit_cast(bf16x8, pw);
                }
                __builtin_amdgcn_sched_barrier(0);
            }
#pragma unroll
            for (int m = 0; m < 2; ++m)
#pragma unroll
                for (int qt = 0; qt < 2; ++qt)
#pragma unroll
                    for (int d = 0; d < 4; ++d) O[m][qt][d] = __builtin_amdgcn_mfma_f32_16x16x32_bf16(vf[d], pb[m][qt], O[m][qt][d], 0, 0, 0);
            __builtin_amdgcn_sched_barrier(0);
        }
    }
#undef DA_TILE_LOAD
#pragma unroll
    for (int qt = 0; qt < 2; ++qt) {
        const float l0 = xsum32(xsum16(ls[0][qt]));
        const float l1 = xsum32(xsum16(ls[1][qt]));
        const float i0 = 1.0f / l0, i1 = lam / l1;
        f32x4 o[4]; float ss = 0.f;
#pragma unroll
        for (int d = 0; d < 4; ++d) { o[d] = O[0][qt][d] * i0 - O[1][qt][d] * i1; ss += (o[d][0] * o[d][0] + o[d][1] * o[d][1]) + (o[d][2] * o[d][2] + o[d][3] * o[d][3]); }
        ss = xsum32(xsum16(ss));
        const float rs = oscale / sqrtf(ss * (1.0f / 64.0f) + NORM_EPS);
        bf16* op = MIX + (size_t)(q0row + qt * 16 + fr) * D + h * 64 + 4 * g;
#pragma unroll
        for (int d = 0; d < 4; ++d) { const f32x4 gn = *(const f32x4*)(normg + d * 16 + 4 * g); const f32x4 r = o[d] * rs * gn;
            u32x2 w; w.x = cvt_pk_bf16(r[0], r[1]); w.y = cvt_pk_bf16(r[2], r[3]); *(u32x2*)(op + d * 16) = w; }
    }
    __syncthreads();
}

template <bool IS_CTX>
__device__ __forceinline__ void na_block(const bf16* P, const bf16* VTB, bf16* MIX, const float* relb, const Frame& F, int b, int h, int blk, const float* kn  ) {
    const int lane = F.lane, fr = lane & 15, g = lane >> 4, tid = F.tid, w = F.wave;
    LAS unsigned char* lds = F.lds;
    const int r = IS_CTX ? 0 : 2 * blk + (w >> 2), qt = w & 3;
    const int cq = IS_CTX ? (blk * 128 + 16 * w + fr) : (16 * qt + fr);
    const int qrow = IS_CTX ? (NLAT + b * CTXL + cq) : (b * SEQ + r * 64 + cq);
    const float SC = 0.125f * LOG2E;
    bf16x8 qf[2];
#pragma unroll
    for (int ks = 0; ks < 2; ++ks) { const u32x4 qw = *(const u32x4*)(P + (size_t)qrow * NPI + B_Q + h * 64 + ks * 32 + 8 * g);
        u32x4 o; o.x = cvt_pk_bf16(bflo(qw.x) * SC, bfhi(qw.x) * SC); o.y = cvt_pk_bf16(bflo(qw.y) * SC, bfhi(qw.y) * SC); o.z = cvt_pk_bf16(bflo(qw.z) * SC, bfhi(qw.z) * SC); o.w = cvt_pk_bf16(bflo(qw.w) * SC, bfhi(qw.w) * SC);
        qf[ks] = __builtin_bit_cast(bf16x8, o); }
    LAS float* biasl = (LAS float*)(lds + 4 * KV_BUF);
    if (!IS_CTX) { if (tid < 15 * 31) biasl[tid] = relb[h * 465 + tid] * LOG2E; }
    const int wlo = qt == 0 ? 0 : (qt == 1 ? 8 : (qt == 2 ? 24 : 32));
    const int rs = min(max(r - 4, 0), 24), cs = min(max(cq - 8, 0), 48);
    const int klo = IS_CTX ? 0 : min(max(2 * blk - 4, 0), 24), khi = IS_CTX ? -1 : (min(max(2 * blk + 1 - 4, 0), 24) + 7);
    const int nlat = khi - klo + 1, ntiles = nlat + 4;
    f32x4 O[4]; float ls = 0.f;
#pragma unroll
    for (int d = 0; d < 4; ++d) O[d] = (f32x4){0.f, 0.f, 0.f, 0.f};
    const bf16* vt = VTB + ((size_t)(b * 8 + h) * 64) * KEYS;
    float mx;
    { float qn2 = 0.f;
#pragma unroll
      for (int ks = 0; ks < 2; ++ks)
#pragma unroll
          for (int j = 0; j < 8; ++j) { const float qv = bf2f((bf16)qf[ks][j]); qn2 += qv * qv; }
      qn2 = xsum32(xsum16(qn2));
      float bm = 0.f;
      if (!IS_CTX) { for (int i2 = lane; i2 < 15 * 31; i2 += 64) bm = fmaxf(bm, relb[h * 465 + i2]);
#pragma unroll
          for (int o = 1; o < 64; o <<= 1) bm = fmaxf(bm, __shfl_xor(bm, o)); }
      const float kmax2 = block_max(kn, IS_CTX ? CTXL : KEYS, F, (volatile LAS float*)(lds + MISC_OFF + 192));
      mx = sqrtf(qn2 * kmax2) + bm * LOG2E; }
    const f32x4 cinit = {-mx, -mx, -mx, -mx};
    const f32x4 zero = {0.f, 0.f, 0.f, 0.f};
    u32x4 kreg, vreg;
#define NA_TILE_LOAD(t) do { const bool lat_ = (t) < nlat; const int kr_ = klo + (t), j0_ = ((t) - nlat) * 64; \
        kv_load(P, vt, B_K + h * 64, lat_ ? (size_t)(b * SEQ + kr_ * 64) : (size_t)(NLAT + b * CTXL + j0_), lat_ ? (CTXL + kr_ * 64) : j0_, tid, kreg, vreg); } while (0)
    NA_TILE_LOAD(0);
    for (int t = 0; t < ntiles; ++t) {
        LAS unsigned char* kb = lds + (t & 1) * 2 * KV_BUF; LAS unsigned char* vb = kb + KV_BUF;
        kv_store(kb, vb, tid, kreg, vreg);
        __syncthreads();
        if (t + 1 < ntiles) NA_TILE_LOAD(t + 1);
        const bool lat = t < nlat;
        const int kr = klo + t;
        if (lat && (kr < rs || kr > rs + 7)) continue;
        const int nst = lat ? 1 : 2;
        for (int st = 0; st < nst; ++st) {
            const int ko = lat ? wlo : 32 * st;
            bf16x8 kf[2][2], vf[4];
#pragma unroll
            for (int kt = 0; kt < 2; ++kt)
#pragma unroll
                for (int ks = 0; ks < 2; ++ks) kf[kt][ks] = *(const LAS bf16x8*)(kb + (ko + kt * 16 + fr) * KV_PITCH + (ks * 32 + 8 * g) * 2);
#pragma unroll
            for (int d = 0; d < 4; ++d) vf[d] = v_frag(vb, d, ko, fr, g);
            f32x4 s[2];
#pragma unroll
            for (int kt = 0; kt < 2; ++kt) { s[kt] = __builtin_amdgcn_mfma_f32_16x16x32_bf16(kf[kt][0], qf[0], cinit, 0, 0, 0); s[kt] = __builtin_amdgcn_mfma_f32_16x16x32_bf16(kf[kt][1], qf[1], s[kt], 0, 0, 0); }
            float v[8];
#pragma unroll
            for (int kt = 0; kt < 2; ++kt)
#pragma unroll
                for (int rr = 0; rr < 4; ++rr) {
                    float x = s[kt][rr];
                    if (lat) { const int ck = wlo + kt * 16 + 4 * g + rr; const bool ok = (ck >= cs) && (ck < cs + 16);
                        const int dr = kr - r + 7, dc = min(max(ck - cq + 15, 0), 30);
                        x = ok ? (x + biasl[dr * 31 + dc]) : -__builtin_inff(); }
                    v[kt * 4 + rr] = x;
                }
            float pp[8];
#pragma unroll
            for (int i = 0; i < 8; ++i) pp[i] = fexp2(v[i]);
            ls += ((pp[0] + pp[1]) + (pp[2] + pp[3])) + ((pp[4] + pp[5]) + (pp[6] + pp[7]));
            u32x4 pw; pw.x = cvt_pk_bf16(pp[0], pp[1]); pw.y = cvt_pk_bf16(pp[2], pp[3]); pw.z = cvt_pk_bf16(pp[4], pp[5]); pw.w = cvt_pk_bf16(pp[6], pp[7]);
            const bf16x8 pb = __builtin_bit_cast(bf16x8, pw);
#pragma unroll
            for (int d = 0; d < 4; ++d) O[d] = __builtin_amdgcn_mfma_f32_16x16x32_bf16(vf[d], pb, O[d], 0, 0, 0);
        }
    }
#undef NA_TILE_LOAD
    const float lt = xsum32(xsum16(ls));
    const float il = 1.0f / lt;
    bf16* op = MIX + (size_t)qrow * D + 512 + h * 64 + 4 * g;
#pragma unroll
    for (int d = 0; d < 4; ++d) { const f32x4 rr = O[d] * il; u32x2 w2; w2.x = cvt_pk_bf16(rr[0], rr[1]); w2.y = cvt_pk_bf16(rr[2], rr[3]); *(u32x2*)(op + d * 16) = w2; }
    __syncthreads();
}

__device__ __forceinline__ int pos_row(int pos, int b, int dir) {
    if (pos < CTXL) { const int j = dir ? (CTXL - 1 - pos) : pos; return NLAT + b * CTXL + j; }
    const int t = pos - CTXL; return b * SEQ + (dir ? (SEQ - 1 - t) : t);
}
template <bool HG>
__device__ __forceinline__ void cd_chunk_seq(KP p, const Frame& F, int l, bool ctx_out, int b, int h, int dir, int colhalf) {
    constexpr int DK = HG ? 128 : 64, DVL = HG ? 64 : 128, C = 64, NCH = KEYS / C;
    constexpr int PK = DK * 2 + 16, PC = 144;
    constexpr int CPT = DK / 64;
    constexpr int VPT = DVL / 64;
    constexpr int KS = DK / 32;
    constexpr int NVT = DVL / 32;
    constexpr int O_QT = 0, O_KT = O_QT + 64 * PK, O_QE = O_KT + 64 * PK, O_KD = O_QE + 64 * PK, O_VT = O_KD + DK * PC, O_PM = O_VT + DVL * PC,
                  O_ST = O_PM + 64 * PC, ST_BYTES = DVL * PK, O_SEG = O_ST + 2 * ST_BYTES, O_DEC = O_SEG + 8 * DK * 4, O_END = O_DEC + DK * 4;
    static_assert(O_END <= RING_BYTES, "cd lds");
    unsigned char* ws = p->ws;
    const bf16* P = (const bf16*)(ws + WS_P);
    const float* LA = HG ? (const float*)(ws + WS_HLA) + (size_t)dir * MT * 512 + h * 128 : (const float*)(ws + WS_LG) + (size_t)dir * MT * 256 + h * 64;
    constexpr int LAW = HG ? 512 : 256;
    float* OUT = (float*)(ws + (HG ? WS_OC : WS_OD)) + (size_t)dir * MT * 512;
    LAS unsigned char* lds = F.lds;
    const int lane = F.lane, w = F.wave, fr = lane & 15, g = lane >> 4;
    const int d0 = CPT * lane;
    const int colbase = HG ? colhalf * 64 : 0;
    const int qcol = HG ? (C_Q + h * 128 + d0) : (D_Q + h * 64 + d0);
    const int kcol = HG ? ((dir ? C_FB : C_FF) + h * 128 + d0) : (D_K + h * 64 + d0);
    const int vcol = (HG ? C_I : D_V) + h * 128 + colbase + VPT * lane;
    const float qscale = HG ? 1.0f : 0.125f;
    const int sdt = HG ? w : (w >> 1), svt0 = HG ? 0 : 4 * (w & 1);
    f32x4 Sacc[4];
#pragma unroll
    for (int t = 0; t < 4; ++t) Sacc[t] = (f32x4){0.f, 0.f, 0.f, 0.f};
    for (int i = F.tid; i < ST_BYTES / 4; i += NTHR) ((LAS unsigned*)(lds + O_ST + ST_BYTES))[i] = 0u;
    unsigned qr[8], kr[8], vr[8]; float lr[8][CPT];
#define CD_PREFETCH(cn) do { \
        _Pragma("unroll") for (int ii = 0; ii < 8; ++ii) { const size_t row = (size_t)pos_row((cn) * C + 8 * w + ii, b, dir); const bf16* pr = P + row * NPI; \
            if (CPT == 2) { qr[ii] = *(const unsigned*)(pr + qcol); kr[ii] = *(const unsigned*)(pr + kcol); const f32x2 t2 = *(const f32x2*)(LA + row * LAW + d0); lr[ii][0] = t2[0]; lr[ii][CPT - 1] = t2[1]; } \
            else { qr[ii] = pr[qcol]; kr[ii] = pr[kcol]; lr[ii][0] = LA[row * LAW + d0]; } \
            if (VPT == 2) vr[ii] = *(const unsigned*)(pr + vcol); else vr[ii] = pr[vcol]; } } while (0)
    CD_PREFETCH(0);
    __syncthreads();
    for (int c = 0; c < NCH; ++c) {
        float la[8][CPT], qq[8][CPT], kk[8][CPT]; unsigned vv[VPT][4];
        float run[CPT];
#pragma unroll
        for (int u = 0; u < CPT; ++u) run[u] = 0.f;
#pragma unroll
        for (int ii = 0; ii < 8; ++ii) {
            if (CPT == 2) { qq[ii][0] = bflo(qr[ii]); qq[ii][CPT - 1] = bfhi(qr[ii]); kk[ii][0] = bflo(kr[ii]); kk[ii][CPT - 1] = bfhi(kr[ii]); }
            else { qq[ii][0] = bflo(qr[ii]) * qscale; kk[ii][0] = bflo(kr[ii]); }
#pragma unroll
            for (int u = 0; u < CPT; ++u) { run[u] += lr[ii][u]; la[ii][u] = run[u]; }
        }
        if (VPT == 2) {
#pragma unroll
            for (int q4 = 0; q4 < 4; ++q4) { vv[0][q4] = (vr[2 * q4] & 0xffffu) | (vr[2 * q4 + 1] << 16); vv[VPT - 1][q4] = (vr[2 * q4] >> 16) | (vr[2 * q4 + 1] & 0xffff0000u); }
        } else {
#pragma unroll
            for (int q4 = 0; q4 < 4; ++q4) vv[0][q4] = (vr[2 * q4] & 0xffffu) | (vr[2 * q4 + 1] << 16);
        }
#pragma unroll
        for (int u = 0; u < CPT; ++u) ((LAS float*)(lds + O_SEG))[w * DK + d0 + u] = run[u];
        if (c + 1 < NCH) CD_PREFETCH(c + 1);
        __syncthreads();
        float off[CPT], rv[CPT], bend[CPT];
#pragma unroll
        for (int u = 0; u < CPT; ++u) { off[u] = 0.f; rv[u] = 0.f; bend[u] = 0.f; }
#pragma unroll
        for (int s2 = 0; s2 < 8; ++s2)
#pragma unroll
            for (int u = 0; u < CPT; ++u) { const float t = ((LAS float*)(lds + O_SEG))[s2 * DK + d0 + u]; off[u] += (s2 < w) ? t : 0.f; rv[u] += (s2 < 4) ? t : 0.f; bend[u] += t; }
        float erv[CPT], ebr[CPT];
#pragma unroll
        for (int u = 0; u < CPT; ++u) { erv[u] = __expf(rv[u]); ebr[u] = __expf(bend[u] - rv[u]); }
        float kdv[8][CPT];
#pragma unroll
        for (int ii = 0; ii < 8; ++ii) {
            float qt[CPT], kt[CPT], qe[CPT];
#pragma unroll
            for (int u = 0; u < CPT; ++u) { const float bi = off[u] + la[ii][u];
                const float x1 = __expf(fminf(fmaxf(bi - rv[u], -60.0f), 60.0f));
                qt[u] = qq[ii][u] * x1; kt[u] = kk[ii][u] * __builtin_amdgcn_rcpf(x1); qe[u] = qt[u] * erv[u]; kdv[ii][u] = kt[u] * ebr[u]; }
            const int i = 8 * w + ii;
            if (CPT == 2) {
                *(LAS unsigned*)(lds + O_QT + i * PK + d0 * 2) = cvt_pk_bf16(qt[0], qt[CPT - 1]);
                *(LAS unsigned*)(lds + O_KT + i * PK + d0 * 2) = cvt_pk_bf16(kt[0], kt[CPT - 1]);
                *(LAS unsigned*)(lds + O_QE + i * PK + d0 * 2) = cvt_pk_bf16(qe[0], qe[CPT - 1]);
            } else {
                *(LAS bf16*)(lds + O_QT + i * PK + d0 * 2) = (bf16)(cvt_pk_bf16(qt[0], 0.f) & 0xffffu);
                *(LAS bf16*)(lds + O_KT + i * PK + d0 * 2) = (bf16)(cvt_pk_bf16(kt[0], 0.f) & 0xffffu);
                *(LAS bf16*)(lds + O_QE + i * PK + d0 * 2) = (bf16)(cvt_pk_bf16(qe[0], 0.f) & 0xffffu);
            }
        }
#pragma unroll
        for (int u = 0; u < CPT; ++u) { u32x4 wv4; wv4.x = cvt_pk_bf16(kdv[0][u], kdv[1][u]); wv4.y = cvt_pk_bf16(kdv[2][u], kdv[3][u]); wv4.z = cvt_pk_bf16(kdv[4][u], kdv[5][u]); wv4.w = cvt_pk_bf16(kdv[6][u], kdv[7][u]);
            *(LAS u32x4*)(lds + O_KD + (d0 + u) * PC + (8 * w) * 2) = wv4; }
#pragma unroll
        for (int u = 0; u < VPT; ++u) { u32x4 wv4; wv4.x = vv[u][0]; wv4.y = vv[u][1]; wv4.z = vv[u][2]; wv4.w = vv[u][3];
            *(LAS u32x4*)(lds + O_VT + (VPT * lane + u) * PC + (8 * w) * 2) = wv4; }
        if (w == 0) {
#pragma unroll
            for (int u = 0; u < CPT; ++u) ((LAS float*)(lds + O_DEC))[d0 + u] = __expf(bend[u]);
        }
        __syncthreads();
        const LAS unsigned char* st_rd = lds + O_ST + ((c + 1) & 1) * ST_BYTES;
        LAS unsigned char* st_wr = lds + O_ST + (c & 1) * ST_BYTES;
        const bool want_out = ctx_out || c >= CTXL / C;
        if (want_out) {
            { const int it = w >> 1, jt0 = 2 * (w & 1);
              bf16x8 bq[KS], ak[2][KS];
#pragma unroll
              for (int ks = 0; ks < KS; ++ks) bq[ks] = *(const LAS bf16x8*)(lds + O_QT + (16 * it + fr) * PK + (ks * 32 + 8 * g) * 2);
#pragma unroll
              for (int t = 0; t < 2; ++t)
#pragma unroll
                  for (int ks = 0; ks < KS; ++ks) ak[t][ks] = *(const LAS bf16x8*)(lds + O_KT + (16 * (jt0 + t) + fr) * PK + (ks * 32 + 8 * g) * 2);
              __builtin_amdgcn_sched_barrier(0);
#pragma unroll
              for (int t = 0; t < 2; ++t) { const int jt = jt0 + t; f32x4 sacc = {0.f, 0.f, 0.f, 0.f};
#pragma unroll
                  for (int ks = 0; ks < KS; ++ks) sacc = __builtin_amdgcn_mfma_f32_16x16x32_bf16(ak[t][ks], bq[ks], sacc, 0, 0, 0);
                  const int i = 16 * it + fr, j0 = 16 * jt + 4 * g;
                  const float m0 = (j0 + 0 <= i) ? sacc[0] : 0.f, m1 = (j0 + 1 <= i) ? sacc[1] : 0.f, m2 = (j0 + 2 <= i) ? sacc[2] : 0.f, m3 = (j0 + 3 <= i) ? sacc[3] : 0.f;
                  u32x2 pw; pw.x = cvt_pk_bf16(m0, m1); pw.y = cvt_pk_bf16(m2, m3);
                  *(LAS u32x2*)(lds + O_PM + i * PC + j0 * 2) = pw; }
            }
            __syncthreads();
            { const int it = w >> 1;
              bf16x8 ap[2], aq[KS], bv[NVT][2], bs[NVT][KS];
#pragma unroll
              for (int ks = 0; ks < 2; ++ks) ap[ks] = *(const LAS bf16x8*)(lds + O_PM + (16 * it + fr) * PC + (ks * 32 + 8 * g) * 2);
#pragma unroll
              for (int ks = 0; ks < KS; ++ks) aq[ks] = *(const LAS bf16x8*)(lds + O_QE + (16 * it + fr) * PK + (ks * 32 + 8 * g) * 2);
#pragma unroll
              for (int t = 0; t < NVT; ++t) { const int vt = (w & 1) * NVT + t;
#pragma unroll
                  for (int ks = 0; ks < 2; ++ks) bv[t][ks] = *(const LAS bf16x8*)(lds + O_VT + (16 * vt + fr) * PC + (ks * 32 + 8 * g) * 2);
#pragma unroll
                  for (int ks = 0; ks < KS; ++ks) bs[t][ks] = *(const LAS bf16x8*)(st_rd + (16 * vt + fr) * PK + (ks * 32 + 8 * g) * 2); }
              __builtin_amdgcn_sched_barrier(0);
              f32x4 oacc[NVT];
#pragma unroll
              for (int t = 0; t < NVT; ++t) { oacc[t] = (f32x4){0.f, 0.f, 0.f, 0.f};
#pragma unroll
                  for (int ks = 0; ks < 2; ++ks) oacc[t] = __builtin_amdgcn_mfma_f32_16x16x32_bf16(ap[ks], bv[t][ks], oacc[t], 0, 0, 0);
#pragma unroll
                  for (int ks = 0; ks < KS; ++ks) oacc[t] = __builtin_amdgcn_mfma_f32_16x16x32_bf16(aq[ks], bs[t][ks], oacc[t], 0, 0, 0); }
              float* orow[4];
#pragma unroll
              for (int r = 0; r < 4; ++r) orow[r] = OUT + (size_t)pos_row(c * C + 16 * it + 4 * g + r, b, dir) * 512 + h * 128 + colbase + (w & 1) * NVT * 16 + fr;
#pragma unroll
              for (int t = 0; t < NVT; ++t)
#pragma unroll
                  for (int r = 0; r < 4; ++r) orow[r][16 * t] = oacc[t][r];
            }
        }
        { bf16x8 ak[2], bv[4][2];
#pragma unroll
          for (int ks = 0; ks < 2; ++ks) ak[ks] = *(const LAS bf16x8*)(lds + O_KD + (16 * sdt + fr) * PC + (ks * 32 + 8 * g) * 2);
          const f32x4 dec4 = *(const LAS f32x4*)(lds + O_DEC + (16 * sdt + 4 * g) * 4);
#pragma unroll
          for (int t = 0; t < 4; ++t)
#pragma unroll
              for (int ks = 0; ks < 2; ++ks) bv[t][ks] = *(const LAS bf16x8*)(lds + O_VT + (16 * (svt0 + t) + fr) * PC + (ks * 32 + 8 * g) * 2);
          __builtin_amdgcn_sched_barrier(0);
#pragma unroll
          for (int t = 0; t < 4; ++t) { const int vt = svt0 + t; Sacc[t] = Sacc[t] * dec4;
#pragma unroll
              for (int ks = 0; ks < 2; ++ks) Sacc[t] = __builtin_amdgcn_mfma_f32_16x16x32_bf16(ak[ks], bv[t][ks], Sacc[t], 0, 0, 0);
              u32x2 sw; sw.x = cvt_pk_bf16(Sacc[t][0], Sacc[t][1]); sw.y = cvt_pk_bf16(Sacc[t][2], Sacc[t][3]);
              *(LAS u32x2*)(st_wr + (16 * vt + fr) * PK + (16 * sdt + 4 * g) * 2) = sw; }
        }
    }
#undef CD_PREFETCH
    __syncthreads();
}

__device__ __forceinline__ void cd_combine_phase(KP p, const Frame& F, int l, bool ctx_out) {
    unsigned char* ws = p->ws;
    const bf16* P = (const bf16*)(ws + WS_P); bf16* MIX = (bf16*)(ws + WS_MIX);
    const int gw = F.bid * NWAVES + F.wave, NGW = F.G * NWAVES, lane = F.lane;
    const int nrows = ctx_out ? MT : NLAT;
    for (int it = gw; it < 2 * nrows; it += NGW) {
        const int mix = it / nrows, m = it % nrows;
        const float* o0 = (const float*)(ws + (mix ? WS_OD : WS_OC)) + (size_t)m * 512 + 8 * lane; const float* o1 = o0 + (size_t)MT * 512;
        const f32x4 a0 = *(const f32x4*)o0 + *(const f32x4*)o1, a1 = *(const f32x4*)(o0 + 4) + *(const f32x4*)(o1 + 4);
        float ss = (a0[0] * a0[0] + a0[1] * a0[1]) + (a0[2] * a0[2] + a0[3] * a0[3]) + (a1[0] * a1[0] + a1[1] * a1[1]) + (a1[2] * a1[2] + a1[3] * a1[3]);
        ss += __shfl_xor(ss, 1); ss += __shfl_xor(ss, 2); ss += __shfl_xor(ss, 4); ss += __shfl_xor(ss, 8);
        const float rstd = 1.0f / sqrtf(ss * (1.0f / 128.0f) + NORM_EPS);
        const float* ng = p->in[mix ? I_GNORM : I_HNORM] + (size_t)l * 128 + ((8 * lane) & 127);
        const f32x4 g0 = *(const f32x4*)ng, g1 = *(const f32x4*)(ng + 4);
        const u32x4 gw4 = *(const u32x4*)(P + (size_t)m * NPI + (mix ? D_R : C_G) + 8 * lane);
        float gt[8] = {bflo(gw4.x), bfhi(gw4.x), bflo(gw4.y), bfhi(gw4.y), bflo(gw4.z), bfhi(gw4.z), bflo(gw4.w), bfhi(gw4.w)};
        float r[8];
#pragma unroll
        for (int j = 0; j < 4; ++j) { r[j] = a0[j] * rstd * g0[j] * fsilu(gt[j]); r[4 + j] = a1[j] * rstd * g1[j] * fsilu(gt[4 + j]); }
        u32x4 w; w.x = cvt_pk_bf16(r[0], r[1]); w.y = cvt_pk_bf16(r[2], r[3]); w.z = cvt_pk_bf16(r[4], r[5]); w.w = cvt_pk_bf16(r[6], r[7]);
        *(u32x4*)(MIX + (size_t)m * D + (mix ? 1536 : 1024) + 8 * lane) = w;
    }
}

constexpr int CD_BLOCKS = 96;
__device__ __forceinline__ void cd_item(KP p, const Frame& F, int l, bool ctx_out, int it) {
    if (it < 64) { const int colhalf = it & 1, dir = (it >> 1) & 1, h = (it >> 2) & 3, b = it >> 4; cd_chunk_seq<true>(p, F, l, ctx_out, b, h, dir, colhalf); }
    else { const int i = it - 64, dir = i & 1, h = (i >> 1) & 3, b = i >> 3; cd_chunk_seq<false>(p, F, l, ctx_out, b, h, dir, 0); }
}
__device__ __forceinline__ void mixer_phase(KP p, const Frame& F, int l, bool ctx_out) {
    unsigned char* ws = p->ws;
    if (F.G >= 256) { if (F.bid < CD_BLOCKS) { cd_item(p, F, l, ctx_out, F.bid); if ((PROBE_DUP) == 31) cd_item(p, F, l, ctx_out, F.bid); } }
    else { for (int it = F.bid; it < CD_BLOCKS; it += F.G) cd_item(p, F, l, ctx_out, it); }
    const bf16* P = (const bf16*)(ws + WS_P); bf16* MIX = (bf16*)(ws + WS_MIX);
    const int x = F.bid & 7;
    unsigned* qhead = (unsigned*)(ws + WS_CTL) + CW_QUEUE + 64 * (8 * l + x);
    volatile LAS unsigned* slot = (volatile LAS unsigned*)(F.lds + MISC_OFF + 64);
    const float* lp = p->in[I_DLAM] + (size_t)l * 128;
    float s01 = 0.f, s23 = 0.f;
    for (int i = 0; i < 32; ++i) { s01 += lp[i] * lp[32 + i]; s23 += lp[64 + i] * lp[96 + i]; }
    const float li = 0.8f - 0.6f * expf(-0.3f * (float)l);
    const float lam = expf(s01) - expf(s23) + li;
    const bf16* VTA = (const bf16*)(ws + WS_VTA); const bf16* VTB = (const bf16*)(ws + WS_VTB);
    const float* ng = p->in[I_DNORM] + (size_t)l * 64;
    const float* relb = p->in[I_RELB] + (size_t)l * 8 * 15 * 31;
    const float* kna = (const float*)(ws + WS_KNA); const float* knb = (const float*)(ws + WS_KNB);
    const int perA = 8 + (ctx_out ? 1 : 0), perB = 16 + (ctx_out ? 2 : 0), nA = 4 * perA, nTot = nA + 4 * perB;
    const int nExtra = ((PROBE_DUP) == 32) ? nTot : ((PROBE_DUP) == 33) ? nA : ((PROBE_DUP) == 34) ? (nTot - nA) : 0;
    for (;;) {
        __syncthreads();
        if (F.tid == 0) *slot = atomicAdd(qhead, 1u);
        __syncthreads();
        int it = (int)*slot;
        if (it >= nTot + nExtra) break;
        if (it >= nTot) it = it - nTot + (((PROBE_DUP) == 34) ? nA : 0);
        if (it < nA) {
            const int bh = x + 8 * (it / perA), j = it % perA, b = bh >> 3, h = bh & 7;
            if (j < 8) diffattn_block(P, VTA, MIX, F, b, h, b * SEQ + j * 256, KEYS / 64, lam, 1.0f - li, ng, kna + (size_t)b * 16 * KEYS, KEYS);
            else diffattn_block(P, VTA, MIX, F, b, h, NLAT + b * CTXL, CTXL / 64, lam, 1.0f - li, ng, kna + (size_t)b * 16 * KEYS, CTXL);
        } else {
            const int i2 = it - nA, bh = x + 8 * (i2 / perB), j = i2 % perB, b = bh >> 3, h = bh & 7;
            if (j < 16) na_block<false>(P, VTB, MIX, relb, F, b, h, j, knb + ((size_t)b * 8 + h) * KEYS);
            else na_block<true>(P, VTB, MIX, relb, F, b, h, j - 16, knb + ((size_t)b * 8 + h) * KEYS);
        }
    }
}

__device__ __forceinline__ void moe_gather_phase(KP p, const Frame& F) {
    unsigned char* ws = p->ws;
    unsigned* ctl = (unsigned*)(ws + WS_CTL);
    volatile LAS int* gtot = (volatile LAS int*)(F.lds + MISC_OFF + 512);
    { const unsigned* bc = (const unsigned*)(ws + WS_BCNT); const int e = F.wave, j = F.lane;
      int v4[4]; int part = 0, mine_before = 0;
#pragma unroll
      for (int q = 0; q < 4; ++q) { const int b2 = 4 * j + q; v4[q] = b2 < F.G ? (int)bc[(size_t)b2 * 8 + e] : 0; part += v4[q]; if (b2 < F.bid) mine_before += v4[q]; }
      int incl = part;
#pragma unroll
      for (int o = 1; o < 64; o <<= 1) { const int t = __shfl_up(incl, o); if (j >= o) incl += t; }
      const int total = __shfl(incl, 63);
      const int excl = incl - part;
      const int jb = F.bid >> 2;
      const int base_e = __shfl(excl, jb) + __shfl(mine_before, jb);
      if (j == 0) { gtot[e] = total; gtot[8 + e] = base_e; gtot[16 + e] = 0; }
    }
    __syncthreads();
    int off[8], bse[8]; int tot = 0;
#pragma unroll
    for (int e = 0; e < 8; ++e) { const int c = gtot[e]; off[e] = tot; bse[e] = tot + gtot[8 + e]; tot += ((c + 255) >> 8) << 8; }
    if (F.bid == 0 && F.tid == 0) {
        ctl[CW_PANEL] = (unsigned)(tot >> 8);
#pragma unroll
        for (int e = 0; e < 8; ++e) { const int pe = (e == 7 ? tot : off[e + 1]) >> 8; for (int q = off[e] >> 8; q < pe; ++q) ctl[CW_PANEL + 1 + q] = (unsigned)e; }
    }
    const bf16* H = (const bf16*)(ws + WS_H); bf16* HS = (bf16*)(ws + WS_HS);
    const unsigned* RT = (const unsigned*)(ws + WS_ROUTE); int* POS = (int*)(ws + WS_POS);
    const int gw = F.bid * NWAVES + F.wave, NGW = F.G * NWAVES;
    for (int m = gw; m < NLAT; m += NGW) {
        const int i0 = (int)RT[(size_t)m * 4], i1 = (int)RT[(size_t)m * 4 + 1];
        int p0 = 0, p1 = 0;
        if (F.lane == 0) { p0 = (int)__hip_atomic_fetch_add((LAS int*)(gtot + 16 + i0), 1, __ATOMIC_RELAXED, __HIP_MEMORY_SCOPE_WORKGROUP); p1 = (int)__hip_atomic_fetch_add((LAS int*)(gtot + 16 + i1), 1, __ATOMIC_RELAXED, __HIP_MEMORY_SCOPE_WORKGROUP); }
        p0 = __shfl(p0, 0); p1 = __shfl(p1, 0);
        int o0 = 0, o1 = 0;
#pragma unroll
        for (int e = 0; e < 8; ++e) { o0 = (e == i0) ? bse[e] : o0; o1 = (e == i1) ? bse[e] : o1; }
        p0 += o0; p1 += o1;
        if (F.lane == 0) { POS[(size_t)m * 2] = p0; POS[(size_t)m * 2 + 1] = p1; }
        const u32x4* src = (const u32x4*)((const unsigned char*)H + (size_t)m * D) + F.lane;
        u32x4* d0 = (u32x4*)((unsigned char*)HS + (size_t)p0 * D) + F.lane; u32x4* d1 = (u32x4*)((unsigned char*)HS + (size_t)p1 * D) + F.lane;
        { const u32x4 va = src[0], vb = src[64]; d0[0] = va; d0[64] = vb; d1[0] = va; d1[64] = vb; }
    }
    __syncthreads();
}

__device__ __forceinline__ void final_phase(KP p, const Frame& F) {
    unsigned char* ws = p->ws;
    const float* X = (const float*)(ws + WS_X); const bf16* Y = (const bf16*)(ws + WS_Y);
    const float* MOD = (const float*)(ws + WS_MOD) + (size_t)1 * 5 * MODW;
    const unsigned* RT = (const unsigned*)(ws + WS_ROUTE); const int* POS = (const int*)(ws + WS_POS);
    const int gw = F.bid * NWAVES + F.wave, NGW = F.G * NWAVES;
    for (int m = gw; m < NLAT; m += NGW) {
        const int b = m >> 11;
        const float w0 = __uint_as_float(RT[(size_t)m * 4 + 2]), w1 = __uint_as_float(RT[(size_t)m * 4 + 3]);
        const int p0 = POS[(size_t)m * 2], p1 = POS[(size_t)m * 2 + 1];
        const f32x4* xr = (const f32x4*)(X + (size_t)m * D) + F.lane; const u32x2* y0 = (const u32x2*)(Y + (size_t)p0 * D) + F.lane; const u32x2* y1 = (const u32x2*)(Y + (size_t)p1 * D) + F.lane;
        const f32x4* gp = (const f32x4*)(MOD + (size_t)b * MODW + 5 * D) + F.lane;
        const int split0 = MOE_FULL_PANELS * 256;
        const f32x4* q0 = (const f32x4*)((const float*)(ws + WS_SPLIT) + (size_t)(p0 - split0) * D) + F.lane; const f32x4* q1 = (const f32x4*)((const float*)(ws + WS_SPLIT) + (size_t)(p1 - split0) * D) + F.lane;
        f32x4 v[8]; float ss = 0.f;
#pragma unroll
        for (int j = 0; j < 8; ++j) {
            f32x4 a0, a1;
            if (p0 < split0) { const u32x2 w = y0[64 * j]; a0 = (f32x4){bflo(w.x), bfhi(w.x), bflo(w.y), bfhi(w.y)}; } else { a0 = q0[64 * j];
#pragma unroll
                for (int ks = 1; ks < MOE_KS; ++ks) a0 = a0 + q0[(size_t)ks * 8 * 256 * D / 4 + 64 * j]; }
            if (p1 < split0) { const u32x2 w = y1[64 * j]; a1 = (f32x4){bflo(w.x), bfhi(w.x), bflo(w.y), bfhi(w.y)}; } else { a1 = q1[64 * j];
#pragma unroll
                for (int ks = 1; ks < MOE_KS; ++ks) a1 = a1 + q1[(size_t)ks * 8 * 256 * D / 4 + 64 * j]; }
            v[j] = xr[64 * j] + gp[64 * j] * (a0 * w0 + a1 * w1); ss += (v[j][0] * v[j][0] + v[j][1] * v[j][1]) + (v[j][2] * v[j][2] + v[j][3] * v[j][3]); }
        const float rstd = 1.0f / sqrtf(wave_sum(ss) * (1.0f / D) + NORM_EPS);
        const f32x4* fn = (const f32x4*)p->in[I_FNORM] + F.lane; f32x4* o = (f32x4*)(p->out + (size_t)m * D) + F.lane;
#pragma unroll
        for (int j = 0; j < 8; ++j) o[64 * j] = v[j] * rstd * fn[64 * j];
    }
}

constexpr int PH_L0 = 1, PH_L1 = 12, PH_END = 23;
#define GRID_BAR() do { XcdBarrier bb_; bb_.bar = (unsigned*)(launder_kp(kp0)->ws + WS_CTL) + CW_BAR; bb_.x = xb_xcc_id(); bb_.st = (volatile LAS unsigned*)(ldsb + MISC_OFF) + 8; xcd_barrier(bb_); } while (0)
#define IN(k) (lo <= (k) && (k) < hi)
#define SEAM(k) do { if (IN(k) && IN((k) + 1)) { GRID_BAR(); if ((PROBE_DUP) == 999) GRID_BAR(); } } while (0)
#define RUNPH(id, ...) do { if ((PROBE_DUP) == (id)) { { __VA_ARGS__ } GRID_BAR(); } { __VA_ARGS__ } } while (0)
#define PHASE_BEGIN() const KP p = launder_kp(kp0); const Frame F = make_frame(ldsb); unsigned char* const ws = p->ws; (void)ws

template <int l>
__device__ __forceinline__ void layer_phases(const KP kp0, LAS unsigned char* const ldsb, const int lo, const int hi) {
        const int base = l == 0 ? PH_L0 : PH_L1;
        const bool ctx_out = (l == 0);
        const int mrows = ctx_out ? MT : NLAT;
        if (IN(base + 0)) { RUNPH(10, PHASE_BEGIN(); norm_phase<false, false, (l == 1) ? 1 : 0>(p, F, l, l == 0, p->in[I_NMIX] + (size_t)l * D, 0, 1, MT); if (l == 1) conv_drain(p, F, CV_L1_ITEMS);); SEAM(base + 0); }
        if (IN(base + 1)) {
            RUNPH(1,
            PHASE_BEGIN();
            pg8::Gemm g{(const bf16*)(ws + WS_H), (const bf16*)(ws + WS_WIN) + (size_t)l * NPI * D, D, D};
            pg8::DenseOrder S; S.init(MT / 256, NPI / 256, F.G, F.bid);
            pg8::EpiBf16 E{(bf16*)(ws + WS_P), NPI};
            pg8::gemm_phase<pg8::EpiBf16, pg8::DenseOrder>(F.lds, F.tid, g, S, E);
            );
            SEAM(base + 1);
        }
        if (IN(base + 2)) { PHASE_BEGIN(); prep_phase(p, F, l, ctx_out); if ((PROBE_DUP) == 2) { GRID_BAR(); prep_phase(p, F, l, ctx_out, 10); } if ((PROBE_DUP) == 21) { GRID_BAR(); prep_phase(p, F, l, ctx_out, 5, (WS_G - WS_P) / 2); } if ((PROBE_DUP) == 23) { GRID_BAR(); prep_phase(p, F, l, ctx_out, 2); } SEAM(base + 2); }
        if (IN(base + 3)) { RUNPH(3, PHASE_BEGIN(); mixer_phase(p, F, l, ctx_out);); SEAM(base + 3); }
        if (IN(base + 4)) { RUNPH(4, PHASE_BEGIN(); cd_combine_phase(p, F, l, ctx_out);); SEAM(base + 4); }
        if (IN(base + 5)) {
            if (l == 0 && (PROBE_DUP) == 5) {
              PHASE_BEGIN();
              { pg8::Gemm g{(const bf16*)(ws + WS_MIX), (const bf16*)(ws + WS_WOUT), D, D};
                pg8::DenseOrder S; S.init(NLAT / 256, D / 256, F.G, F.bid);
                pg8::EpiResid E{p->in[I_X], p->in[I_CTX], (float*)(ws + WS_X), (const float*)(ws + WS_MOD) + 2 * D};
                pg8::gemm_phase<pg8::EpiResid, pg8::DenseOrder>(F.lds, F.tid, g, S, E); }
              { pg8::Gemm g{(const bf16*)(ws + WS_MIX), (const bf16*)(ws + WS_WOUT), D / OUT_KS, D};
                pg8::SplitOrder S{NLAT / 256, NCTX / 256, D / 256, OUT_KS, 2 * D / OUT_KS, F.G, F.bid, nullptr};
                pg8::EpiPart E{(float*)(ws + WS_SPLIT), D, NLAT / 256, (size_t)NCTX * D};
                pg8::gemm_phase<pg8::EpiPart, pg8::SplitOrder>(F.lds, F.tid, g, S, E); }
              GRID_BAR();
            }
            PHASE_BEGIN();
            { pg8::Gemm g{(const bf16*)(ws + WS_MIX), (const bf16*)(ws + WS_WOUT) + (size_t)l * D * D, D, D};
              pg8::DenseOrder S; S.init(NLAT / 256, D / 256, F.G, F.bid);
              const float* xs = (const float*)(ws + WS_X);
              pg8::EpiResid E{l == 0 ? p->in[I_X] : xs, l == 0 ? p->in[I_CTX] : xs + (size_t)NLAT * D, (float*)(ws + WS_X), (const float*)(ws + WS_MOD) + (size_t)l * 5 * MODW + 2 * D};
              pg8::gemm_phase<pg8::EpiResid, pg8::DenseOrder>(F.lds, F.tid, g, S, E); }
            if (l == 0) {
              pg8::Gemm g{(const bf16*)(ws + WS_MIX), (const bf16*)(ws + WS_WOUT) + (size_t)l * D * D, D / OUT_KS, D};
              pg8::SplitOrder S{NLAT / 256, NCTX / 256, D / 256, OUT_KS, 2 * D / OUT_KS, F.G, F.bid, nullptr};
              pg8::EpiPart E{(float*)(ws + WS_SPLIT), D, NLAT / 256, (size_t)NCTX * D};
              pg8::gemm_phase<pg8::EpiPart, pg8::SplitOrder>(F.lds, F.tid, g, S, E); }
            SEAM(base + 5);
        }
        if (l == 0) {
            if (IN(base + 6)) { RUNPH(6, PHASE_BEGIN(); norm_phase<false, (FFU_FP8) != 0, 2>(p, F, l, false, p->in[I_NFFN] + (size_t)l * D, 3, 4, MT);); SEAM(base + 6); }
            if (IN(base + 7)) {
                RUNPH(7,
                PHASE_BEGIN();
                pg8::Gemm g{(const bf16*)(ws + WS_H), (const bf16*)(ws + WS_W13), (FFU_FP8) ? D / 2 : D, (FFU_FP8) ? D / 2 : D};
                if (F.bid < FFU_GEMM_WGS) {
                    pg8::DenseOrder S; S.init(MT / 256, 2 * FFD / 256, FFU_GEMM_WGS, F.bid);
                    pg8::EpiSwiglu8 E{(unsigned char*)(ws + WS_G), FFD};
                    pg8::gemm_phase<pg8::EpiSwiglu8, pg8::DenseOrder, true, true, (FFU_FP8) != 0>(F.lds, F.tid, g, S, E);
                }
                conv_drain(p, F, CV_L1_ITEMS + CV_FFU_ITEMS);
                );
                SEAM(base + 7);
            }
            if (IN(base + 8)) {
                PHASE_BEGIN();
                if ((PROBE_DUP) == 9) {
                  { pg8::Gemm g{(const bf16*)(ws + WS_G), (const bf16*)(ws + WS_W2), FFD / 2, FFD / 2};
                    pg8::DenseOrder S; S.init(NLAT / 256, D / 256, F.G, F.bid);
                    pg8::EpiF32 E{(float*)(ws + WS_Y), D};
                    pg8::gemm_phase<pg8::EpiF32, pg8::DenseOrder, true, true, true>(F.lds, F.tid, g, S, E); }
                  { pg8::Gemm g{(const bf16*)(ws + WS_G), (const bf16*)(ws + WS_W2), FFD / FFD_KS / 2, FFD / 2};
                    pg8::SplitOrder S{NLAT / 256, NCTX / 256, D / 256, FFD_KS, FFD / FFD_KS, F.G, F.bid, nullptr};
                    pg8::EpiPart E{(float*)(ws + WS_SPLIT), D, NLAT / 256, (size_t)NCTX * D};
                    pg8::gemm_phase<pg8::EpiPart, pg8::SplitOrder, true, true, true>(F.lds, F.tid, g, S, E); }
                  GRID_BAR();
                }
                { pg8::Gemm g{(const bf16*)(ws + WS_G), (const bf16*)(ws + WS_W2), FFD / 2, FFD / 2};
                  pg8::DenseOrder S; S.init(NLAT / 256, D / 256, F.G, F.bid);
                  const float* xs = (const float*)(ws + WS_X);
                  pg8::EpiResid E{xs, xs + (size_t)NLAT * D, (float*)(ws + WS_X), (const float*)(ws + WS_MOD) + (size_t)l * 5 * MODW + 5 * D};
                  pg8::gemm_phase<pg8::EpiResid, pg8::DenseOrder, true, true, true>(F.lds, F.tid, g, S, E); }
                { pg8::Gemm g{(const bf16*)(ws + WS_G), (const bf16*)(ws + WS_W2), FFD / FFD_KS / 2, FFD / 2};
                  pg8::SplitOrder S{NLAT / 256, NCTX / 256, D / 256, FFD_KS, FFD / FFD_KS, F.G, F.bid, nullptr};
                  pg8::EpiPart E{(float*)(ws + WS_SPLIT), D, NLAT / 256, (size_t)NCTX * D};
                  pg8::gemm_phase<pg8::EpiPart, pg8::SplitOrder, true, true, true>(F.lds, F.tid, g, S, E); }
                SEAM(base + 8);
            }
        } else {
            if (IN(base + 6)) { PHASE_BEGIN();
                if ((PROBE_DUP) == 16) { norm_phase<true, true>(p, F, l, false, p->in[I_NFFN] + (size_t)l * D, 3, 4, NLAT); GRID_BAR(); if (F.bid == 0 && F.tid < 8) ((unsigned*)(ws + WS_CTL))[CW_CNT + F.tid] = 0u; GRID_BAR(); }
                norm_phase<true, true>(p, F, l, false, p->in[I_NFFN] + (size_t)l * D, 3, 4, NLAT); SEAM(base + 6); }
            if (IN(base + 7)) { PHASE_BEGIN();
                if ((PROBE_DUP) == 17) { moe_gather_phase(p, F); GRID_BAR(); if (F.bid == 0 && F.tid < 8) ((unsigned*)(ws + WS_CTL))[CW_CUR + F.tid] = 0u; GRID_BAR(); }
                moe_gather_phase(p, F); conv_drain(p, F, CV_L1_ITEMS + CV_FFU_ITEMS);
                if ((PROBE_DUP) == 107) { GRID_BAR(); if (F.bid == 0 && F.tid == 0) __hip_atomic_store((unsigned*)(ws + WS_CTL) + CW_CONV, (unsigned)CV_L1_ITEMS, __ATOMIC_RELAXED, __HIP_MEMORY_SCOPE_AGENT); GRID_BAR(); conv_drain(p, F, CV_DEF_ITEMS); }
                SEAM(base + 7); }
            if (IN(base + 8)) {
                RUNPH(108,
                PHASE_BEGIN();
                const unsigned* ctl = (const unsigned*)(ws + WS_CTL);
                volatile LAS unsigned char* pe = (volatile LAS unsigned char*)(F.lds + MISC_OFF + 256);
                const int np = (int)ctl[CW_PANEL];
                if (F.tid < 128) pe[F.tid] = (unsigned char)(F.tid < np ? ctl[CW_PANEL + 1 + F.tid] : 0u);
                __syncthreads();
                pg8::Gemm g{(const bf16*)(ws + WS_HS), (const bf16*)(ws + WS_W13E), D / 2, D / 2};
                const int units = np * (2 * FFE / 256), rounds = (units + F.G - 1) / F.G + 1, gw = (((units + rounds - 1) / rounds) + 7) & ~7;
                if (F.bid < gw) {
                    pg8::MoeOrder S; S.init(np, 2 * FFE / 256, gw, F.bid); S.pe = pe;
                    pg8::EpiSwiglu8 E{(unsigned char*)(ws + WS_G), FFE};
                    pg8::gemm_phase<pg8::EpiSwiglu8, pg8::MoeOrder, true, true, true>(F.lds, F.tid, g, S, E);
                }
                conv_drain(p, F, CV_DEF_ITEMS);
                );
                SEAM(base + 8);
            }
            if (IN(base + 9)) {
                RUNPH(109,
                PHASE_BEGIN();
                const unsigned* ctl = (const unsigned*)(ws + WS_CTL);
                volatile LAS unsigned char* pe = (volatile LAS unsigned char*)(F.lds + MISC_OFF + 256);
                const int np = (int)ctl[CW_PANEL];
                if (F.tid < 128) pe[F.tid] = (unsigned char)(F.tid < np ? ctl[CW_PANEL + 1 + F.tid] : 0u);
                __syncthreads();
                const int nfull = np < MOE_FULL_PANELS ? np : MOE_FULL_PANELS;
                { pg8::Gemm g{(const bf16*)(ws + WS_G), (const bf16*)(ws + WS_W2E), FFE / 2, FFE / 2};
                  pg8::MoeOrder S; S.init(nfull, D / 256, F.G, F.bid); S.pe = pe;
                  pg8::EpiBf16 E{(bf16*)(ws + WS_Y), D};
                  pg8::gemm_phase<pg8::EpiBf16, pg8::MoeOrder, true, true, true>(F.lds, F.tid, g, S, E); }
                if (np > nfull) {
                  pg8::Gemm g{(const bf16*)(ws + WS_G), (const bf16*)(ws + WS_W2E), FFE / MOE_KS / 2, FFE / 2};
                  pg8::SplitOrder S{MOE_FULL_PANELS, np - nfull, D / 256, MOE_KS, FFE / MOE_KS, F.G, F.bid, pe};
                  pg8::EpiPart E{(float*)(ws + WS_SPLIT), D, MOE_FULL_PANELS, (size_t)8 * 256 * D};
                  pg8::gemm_phase<pg8::EpiPart, pg8::SplitOrder, true, true, true>(F.lds, F.tid, g, S, E); }
                );
                SEAM(base + 9);
            }
            if (IN(base + 10)) { RUNPH(22, PHASE_BEGIN(); final_phase(p, F);); }
        }
}

__global__ void __launch_bounds__(NTHR, 2) fwd_kernel(Params pv) {
    extern __shared__ __attribute__((aligned(16))) unsigned char lds_raw[];
    LAS unsigned char* const ldsb = (LAS unsigned char*)lds_raw;
    const KP kp0 = (KP)__builtin_amdgcn_kernarg_segment_ptr();
    { volatile LAS unsigned* MISC = (volatile LAS unsigned*)(ldsb + MISC_OFF);
      for (int u = threadIdx.x; u < 256; u += NTHR) MISC[u] = 0u; }
    __syncthreads();
    const int lo = kp0->ph_lo, hi = kp0->ph_hi;
    if ((hi - lo) > 1) (void)xcd_barrier_post((unsigned*)(kp0->ws + WS_CTL) + CW_BAR, (volatile LAS unsigned*)(ldsb + MISC_OFF) + 8);
    if (IN(0)) { RUNPH(0, PHASE_BEGIN(); p0_prologue(p, F);); SEAM(0); }
    layer_phases<0>(kp0, ldsb, lo, hi);
    layer_phases<1>(kp0, ldsb, lo, hi);
}
#undef IN
#undef SEAM
#undef GRID_BAR
#undef RUNPH
#undef PHASE_BEGIN

extern "C" void kernel_launch(void* const* d_in, const int* in_sizes, int n_in, void* d_out, int out_size, void* d_ws, size_t ws_size, hipStream_t stream) {
    static int grid = 0;
    if (grid == 0) {
        if (n_in != 26 || out_size != NLAT * D || ws_size < WS_END) { fprintf(stderr, "kernel_launch: unexpected shapes (n_in %d out %d ws %zu need %zu)\n", n_in, out_size, ws_size, (size_t)WS_END); grid = -1; return; }
        int dev = 0, cus = 0, per_cu = 0;
        if (hipGetDevice(&dev) != hipSuccess || hipDeviceGetAttribute(&cus, hipDeviceAttributeMultiprocessorCount, dev) != hipSuccess) { grid = -1; return; }
        if (hipFuncSetAttribute((const void*)fwd_kernel, hipFuncAttributeMaxDynamicSharedMemorySize, LDS_BYTES) != hipSuccess) { fprintf(stderr, "kernel_launch: hipFuncSetAttribute failed\n"); grid = -1; return; }
        if (hipOccupancyMaxActiveBlocksPerMultiprocessor(&per_cu, (const void*)fwd_kernel, NTHR, LDS_BYTES) != hipSuccess || per_cu < 1) fprintf(stderr, "kernel_launch: occupancy query says %d\n", per_cu);
        (void)hipGetLastError();
        grid = cus;
    }
    if (grid < 0) return;
    (void)hipMemsetAsync((char*)d_ws + WS_CTL, 0, CTL_BYTES, stream);
    Params p{};
    for (int i = 0; i < 26; ++i) p.in[i] = (const float*)d_in[i];
    p.out = (float*)d_out; p.ws = (unsigned char*)d_ws;
#if MK_ONE_LAUNCH
    p.ph_lo = 0; p.ph_hi = PH_END;
    hipLaunchKernelGGL(fwd_kernel, dim3(grid), dim3(NTHR), LDS_BYTES, stream, p);
#else
    const int phases[] = {0, 1, 2, 3, 4, 5, 6, 7, 8, 9, 12, 13, 14, 15, 16, 17, 18, 19, 20, 21, 22};
    for (int i = 0; i < (int)(sizeof(phases) / sizeof(phases[0])); ++i) { p.ph_lo = phases[i]; p.ph_hi = phases[i] + 1; hipLaunchKernelGGL(fwd_kernel, dim3(grid), dim3(NTHR), LDS_BYTES, stream, p); }
#endif
}
```

```cpp
#include <hip/hip_runtime.h>
#include <cstdio>
#include <cstdint>

#ifndef PROBE_DUP
#define PROBE_DUP -1
#endif
#ifndef MK_ONE_LAUNCH
#define MK_ONE_LAUNCH 1
#endif
#ifndef FFU_FP8
#define FFU_FP8 1
#endif

#define GAS __attribute__((address_space(1)))
#define LAS __attribute__((address_space(3)))
typedef unsigned short bf16;
typedef short bf16x8 __attribute__((ext_vector_type(8)));
typedef float f32x4 __attribute__((ext_vector_type(4)));
typedef float f32x2 __attribute__((ext_vector_type(2)));
typedef unsigned u32x4 __attribute__((ext_vector_type(4)));
typedef unsigned u32x2 __attribute__((ext_vector_type(2)));

constexpr int D = 2048, NB = 4, SEQ = 2048, CTXL = 256, NLAT = NB * SEQ, NCTX = NB * CTXL, MT = NLAT + NCTX;
constexpr int KEYS = CTXL + SEQ;
constexpr int INW = 7200;
constexpr int NPI = 7168;
constexpr int FFD = 5632, FFE = 7168, NEXP = 8;
constexpr int MODW = 6 * D;
constexpr int A_Q = 0, A_K = 512, A_V = 1024, B_Q = 1536, B_K = 2048, B_V = 2560, C_Q = 3072, C_I = 3584, C_FF = 4096, C_FB = 4608, C_G = 5120,
              D_Q = 5632, D_K = 5888, D_V = 6144, D_R = 6656;
constexpr int Z_SRC = 6656;
constexpr float LOG2E = 1.4426950408889634f;
constexpr float NORM_EPS = 1e-6f;

constexpr size_t MiB = 1u << 20;
constexpr size_t al(size_t x) { return (x + 255) & ~(size_t)255; }
constexpr size_t WS_CTL = 0, CTL_BYTES = 1 * MiB;
constexpr size_t WS_MOD = WS_CTL + CTL_BYTES;
constexpr size_t WS_ROUTE = WS_MOD + al((size_t)2 * 5 * MODW * 4);
constexpr size_t WS_POS = WS_ROUTE + al((size_t)NLAT * 16);
constexpr size_t WS_Z = WS_POS + al((size_t)NLAT * 8);
constexpr size_t WS_WZT = WS_Z + al((size_t)MT * 32 * 4);
constexpr size_t WS_WIN = WS_WZT + al((size_t)2 * 32 * D * 2);
constexpr size_t WS_WOUT = WS_WIN + al((size_t)2 * NPI * D * 2);
constexpr size_t WS_W13 = WS_WOUT + al((size_t)2 * D * D * 2);
constexpr size_t WS_W2 = WS_W13 + al((size_t)2 * FFD * D * 2);
constexpr size_t WS_W13E = WS_W2 + al((size_t)D * FFD * 2);
constexpr size_t WS_W2E = WS_W13E + al((size_t)NEXP * 2 * FFE * D * 2);
constexpr size_t WS_X = WS_W2E + al((size_t)NEXP * D * FFE * 2);
constexpr size_t WS_H = WS_X + al((size_t)MT * D * 4);
constexpr size_t WS_P = WS_H + al((size_t)MT * D * 2);
constexpr size_t WS_MIX = WS_P + al((size_t)MT * NPI * 2);
constexpr size_t WS_VTA = WS_MIX + al((size_t)MT * D * 2);
constexpr size_t WS_VTB = WS_VTA + al((size_t)NB * 8 * 64 * KEYS * 2);
constexpr size_t WS_OC = WS_VTB + al((size_t)NB * 8 * 64 * KEYS * 2);
constexpr size_t WS_OD = WS_OC + al((size_t)2 * MT * 512 * 4);
constexpr int MPAD = 18432;
constexpr size_t WS_G = WS_OD + al((size_t)2 * MT * 512 * 4);
constexpr size_t WS_LG = WS_G + al((size_t)MPAD * FFE * 2);
constexpr size_t WS_HLA = WS_LG + al((size_t)2 * MT * 256 * 4);
constexpr int FFD_KS = 11, MOE_KS = 7, MOE_FULL_PANELS = 64, OUT_KS = 4;
constexpr size_t WS_SPLIT = WS_HLA + al((size_t)2 * MT * 512 * 4);
constexpr size_t WS_KNA = WS_SPLIT + al((size_t)MOE_KS * 8 * 256 * D * 4);
constexpr size_t WS_KNB = WS_KNA + al((size_t)NB * 16 * KEYS * 4);
constexpr size_t WS_BCNT = WS_KNB + al((size_t)NB * 8 * KEYS * 4);
constexpr size_t WS_END = WS_BCNT + al((size_t)1024 * 8 * 4);
constexpr size_t WS_Y = WS_P;
constexpr size_t WS_HS = WS_OC;
static_assert((size_t)MPAD * D * 4 <= (size_t)MT * NPI * 2 + (size_t)MT * D * 2 + 512, "Y alias");
static_assert((size_t)MPAD * D * 2 <= (size_t)4 * MT * 512 * 4, "HS alias");
constexpr int CW_BAR = 4096;
constexpr int CW_CNT = 8192;
constexpr int CW_CUR = 8192 + 64;
constexpr int CW_PANEL = 8192 + 128;
constexpr int CW_CONV = 12288;
constexpr int CW_CONV0 = 12352;
constexpr int CW_KMAX = 24576;
constexpr int CW_QUEUE = 16384;

constexpr int RING_BYTES = 131072;
constexpr int MISC_OFF = RING_BYTES;
constexpr int LDS_BYTES = 147456;
constexpr int NWAVES = 8, NTHR = 512;

__device__ __forceinline__ float bf2f(bf16 b) { return __uint_as_float(((unsigned)b) << 16); }
__device__ __forceinline__ float bflo(unsigned w) { return __uint_as_float(w << 16); }
__device__ __forceinline__ float bfhi(unsigned w) { return __uint_as_float(w & 0xffff0000u); }
typedef __bf16 bf16x2_t __attribute__((ext_vector_type(2)));
__device__ __forceinline__ unsigned cvt_pk_bf16(float lo, float hi) { const f32x2 v = {lo, hi}; return __builtin_bit_cast(unsigned, __builtin_convertvector(v, bf16x2_t)); }
__device__ __forceinline__ float wave_sum(float v) {
#pragma unroll
    for (int o = 1; o < 64; o <<= 1) v += __shfl_xor(v, o);
    return v;
}
__device__ __forceinline__ unsigned cvt4_fp8(float a, float b, float c, float d) { unsigned w = 0; w = __builtin_amdgcn_cvt_pk_fp8_f32(a, b, w, false); w = __builtin_amdgcn_cvt_pk_fp8_f32(c, d, w, true); return w; }
constexpr float W8_SCALE = 64.0f;
__device__ __forceinline__ float xmax16(float x) { const unsigned u = __float_as_uint(x); const auto r = __builtin_amdgcn_permlane16_swap(u, u, false, false); return fmaxf(__uint_as_float(r[0]), __uint_as_float(r[1])); }
__device__ __forceinline__ float xmax32(float x) { const unsigned u = __float_as_uint(x); const auto r = __builtin_amdgcn_permlane32_swap(u, u, false, false); return fmaxf(__uint_as_float(r[0]), __uint_as_float(r[1])); }
__device__ __forceinline__ float xsum16(float x) { const unsigned u = __float_as_uint(x); const auto r = __builtin_amdgcn_permlane16_swap(u, u, false, false); return __uint_as_float(r[0]) + __uint_as_float(r[1]); }
__device__ __forceinline__ float xsum32(float x) { const unsigned u = __float_as_uint(x); const auto r = __builtin_amdgcn_permlane32_swap(u, u, false, false); return __uint_as_float(r[0]) + __uint_as_float(r[1]); }
__device__ __forceinline__ float fexp2(float x) { return __builtin_amdgcn_exp2f(x); }
__device__ __forceinline__ float fsigmoid(float x) { return 1.0f / (1.0f + __expf(-x)); }
__device__ __forceinline__ float fsilu(float x) { return x / (1.0f + __expf(-x)); }
#define LDS_WAIT() asm volatile("s_waitcnt lgkmcnt(0)" ::: "memory")

#define XB_TMO      128
#define XB_XCNT(j)  (256  + 64 * (j))
#define XB_XSUB(j)  (1280 + 64 * (j))
#define XB_XGEN(j)  (2304 + 64 * (j))
#define XB_TOP      3328
#define XB_TOPGEN   3392
#define XCD_BAR_WORDS 3456
#define XB_SPIN_CAP (1u << 18)
__device__ __forceinline__ unsigned xb_ld(unsigned* p)              { return __hip_atomic_load(p, __ATOMIC_RELAXED, __HIP_MEMORY_SCOPE_AGENT); }
__device__ __forceinline__ unsigned xb_add(unsigned* p, unsigned v) { return __hip_atomic_fetch_add(p, v, __ATOMIC_RELAXED, __HIP_MEMORY_SCOPE_AGENT); }
__device__ __forceinline__ unsigned xb_xcc_id() { return (unsigned)__builtin_amdgcn_s_getreg((3 << 11) | 20) & 0xFu; }
#define XB_SPIN(cond, bar) do { unsigned _sp = 0; while (cond) { __builtin_amdgcn_s_sleep(1); \
    if ((++_sp & 255u) == 0u) { if (xb_ld(&(bar)[XB_TMO])) break; if (_sp > XB_SPIN_CAP) { atomicAdd(&(bar)[XB_TMO], 1u); break; } } } } while (0)
struct XcdBarrier { unsigned* bar; unsigned x; volatile LAS unsigned* st; };
__device__ __forceinline__ XcdBarrier xcd_barrier_post(unsigned* bar, volatile LAS unsigned* st) {
    XcdBarrier b; b.bar = bar; b.x = xb_xcc_id(); b.st = st;
    if (threadIdx.x == 0) (void)xb_add(&bar[XB_XCNT(b.x)], 1u);
    return b;
}
__device__ __forceinline__ void xcd_barrier_complete(unsigned* bar, unsigned x, unsigned& nloc, unsigned& nx) {
    const unsigned G = gridDim.x * gridDim.y * gridDim.z;
    unsigned sum, cnt, mine, sp = 0u;
    for (;;) {
        sum = 0u; cnt = 0u; mine = 0u;
#pragma unroll
        for (unsigned j = 0; j < 16; ++j) { const unsigned c = xb_ld(&bar[XB_XCNT(j)]); sum += c; cnt += (c > 0u) ? 1u : 0u; mine = (j == x) ? c : mine; }
        if (sum == G) break;
        __builtin_amdgcn_s_sleep(1);
        if ((++sp & 255u) == 0u) { if (xb_ld(&bar[XB_TMO])) break; if (sp > XB_SPIN_CAP) { atomicAdd(&bar[XB_TMO], 1u); break; } }
    }
    nloc = mine > 0u ? mine : 1u; nx = cnt > 0u ? cnt : 1u;
}
__device__ __forceinline__ void xcd_barrier(const XcdBarrier& b) {
    asm volatile("s_waitcnt vmcnt(0)" ::: "memory");
    __syncthreads();
    if (threadIdx.x == 0) {
        unsigned* bar = b.bar;
        __builtin_amdgcn_s_waitcnt(0);
        unsigned nloc = b.st[0], nx = b.st[1];
        if (nloc == 0u) { xcd_barrier_complete(bar, b.x, nloc, nx); b.st[0] = nloc; b.st[1] = nx; }
        const unsigned old = xb_add(&bar[XB_XSUB(b.x)], 1u);
        const unsigned gen = old / nloc;
        if (old + 1u == (gen + 1u) * nloc) {
            __builtin_amdgcn_fence(__ATOMIC_RELEASE, "agent");
            asm volatile("s_waitcnt vmcnt(0)" ::: "memory");
            const unsigned og = xb_add(&bar[XB_TOP], 1u);
            const unsigned tg = og / nx;
            if (og + 1u == (tg + 1u) * nx) xb_add(&bar[XB_TOPGEN], 1u);
            else XB_SPIN(xb_ld(&bar[XB_TOPGEN]) == tg, bar);
            __builtin_amdgcn_fence(__ATOMIC_ACQUIRE, "agent");
            xb_add(&bar[XB_XGEN(b.x)], 1u);
            asm volatile("s_waitcnt vmcnt(0)" ::: "memory");
        } else {
            XB_SPIN(xb_ld(&bar[XB_XGEN(b.x)]) == gen, bar);
            __builtin_amdgcn_fence(__ATOMIC_ACQUIRE, "agent");
            asm volatile("s_waitcnt vmcnt(0)" ::: "memory");
        }
    }
    __syncthreads();
}

namespace pg8 {
#define PG8_LAS __attribute__((address_space(3)))
constexpr int BM = 256, BK = 64, HALF = 128, HTB = HALF * BK * 2, STAGE_BYTES = 8 * HTB, NXCD = 8, WGM = 8;
__host__ __device__ __forceinline__ int lds_byte(int r, int c) { const int st = (r >> 4) * 2 + (c >> 5), rr = r & 15, cc = c & 31, ob = rr * 64 + cc * 2; return st * 1024 + (ob ^ (((ob >> 9) & 1) << 5)); }
__host__ __device__ __forceinline__ void stage_rc(int b, int& R, int& C) { const int st = b / 1024, sb = b % 1024, swz = sb ^ (((sb >> 9) & 1) << 5); R = (st >> 1) * 16 + swz / 64; C = (st & 1) * 32 + (swz % 64) / 2; }
__host__ __device__ __forceinline__ int perm32(int rho) { const int n = rho >> 4, i = rho & 15; return 8 * (i >> 2) + 4 * n + (i & 3); }

typedef int i32x4 __attribute__((ext_vector_type(4)));
typedef int i32x8 __attribute__((ext_vector_type(8)));
typedef short s16x16 __attribute__((ext_vector_type(16)));
__device__ __forceinline__ i32x8 cat8(const bf16x8 lo, const bf16x8 hi) { const i32x4 a = __builtin_bit_cast(i32x4, lo), b = __builtin_bit_cast(i32x4, hi); return __builtin_shufflevector(a, b, 0, 1, 2, 3, 4, 5, 6, 7); }
struct Unit { int pm, pn, pb, koff, ks; };
struct Gemm { const bf16* A; const bf16* Bt; int K; int ld; };

struct TileOrder {
    int nM, nN, nwg, G, c;
    __device__ __forceinline__ void init(int nM_, int nN_, int G_, int c_) { nM = nM_; nN = nN_; nwg = nM * nN; G = G_; c = c_; }
    __device__ __forceinline__ bool tile(int i, int& pm, int& pn) const {
        const long L = (long)i * G + c; if (L >= nwg) return false;
        int wgid = (int)L; { const int q = nwg / NXCD, r = nwg % NXCD, xcd = wgid % NXCD, off = wgid / NXCD; wgid = (xcd < r ? xcd * (q + 1) : r * (q + 1) + (xcd - r) * q) + off; }
        const int nig = WGM * nN, gid = wgid / nig, fm = gid * WGM, gsz = (nM - fm) < WGM ? (nM - fm) : WGM;
        pm = fm + ((wgid % nig) % gsz); pn = (wgid % nig) / gsz; return true;
    }
};
struct DenseOrder : TileOrder {
    __device__ __forceinline__ bool next(int i, Unit& u) const { if (!tile(i, u.pm, u.pn)) return false; u.pb = u.pn; u.koff = 0; u.ks = 0; return true; }
    __device__ __forceinline__ void a_ready(const Unit&) const {}
    __device__ __forceinline__ void done(const Unit&) const {}
};
struct MoeOrder : TileOrder {
    const volatile PG8_LAS unsigned char* pe;
    __device__ __forceinline__ bool next(int i, Unit& u) const { if (!tile(i, u.pm, u.pn)) return false; u.pb = (int)pe[u.pm] * nN + u.pn; u.koff = 0; u.ks = 0; return true; }
    __device__ __forceinline__ void a_ready(const Unit&) const {}
    __device__ __forceinline__ void done(const Unit&) const {}
};

struct SplitOrder {
    int pm0, npan, nN, nks, kbytes, G, c; const volatile PG8_LAS unsigned char* pe;
    __device__ __forceinline__ bool next(int i, Unit& u) const {
        const long L = (long)i * G + c; if (L >= (long)npan * nN * nks) return false;
        const int l = (int)L; u.ks = l % nks; const int t = l / nks; u.pn = t % nN; u.pm = pm0 + t / nN; u.koff = u.ks * kbytes;
        u.pb = pe ? (int)pe[u.pm] * nN + u.pn : u.pn; return true;
    }
    __device__ __forceinline__ void a_ready(const Unit&) const {}
    __device__ __forceinline__ void done(const Unit&) const {}
};
struct EpiBf16 {
    static constexpr bool PERM = true, AFTER_DRAIN = false;
    bf16* O; int ldc;
    __device__ __forceinline__ void operator()(const f32x4 (&acc)[2][2][4][2], const Unit& u, int wr, int wc, int fr, int fq) const {
        const int row0 = u.pm * BM + wr * 64 + fr, col0 = u.pn * BM + wc * 32 + 8 * fq;
#pragma unroll
        for (int ai = 0; ai < 2; ++ai)
#pragma unroll
            for (int m = 0; m < 4; ++m) { bf16* rowp = O + (size_t)(row0 + ai * HALF + m * 16) * ldc + col0;
#pragma unroll
                for (int bj = 0; bj < 2; ++bj) { const f32x4 v0 = acc[ai][bj][m][0], v1 = acc[ai][bj][m][1];
                    u32x4 w; w.x = cvt_pk_bf16(v0[0], v0[1]); w.y = cvt_pk_bf16(v0[2], v0[3]); w.z = cvt_pk_bf16(v1[0], v1[1]); w.w = cvt_pk_bf16(v1[2], v1[3]);
                    *(u32x4*)(rowp + bj * HALF) = w; } }
    }
};
struct EpiSwiglu {
    static constexpr bool PERM = true, AFTER_DRAIN = false;
    bf16* O; int ldc;
    __device__ __forceinline__ void operator()(const f32x4 (&acc)[2][2][4][2], const Unit& u, int wr, int wc, int fr, int fq) const {
        const int row0 = u.pm * BM + wr * 64 + fr, col0 = u.pn * HALF + wc * 32 + 8 * fq;
#pragma unroll
        for (int ai = 0; ai < 2; ++ai)
#pragma unroll
            for (int m = 0; m < 4; ++m) { bf16* rowp = O + (size_t)(row0 + ai * HALF + m * 16) * ldc + col0;
                float o[8];
#pragma unroll
                for (int n = 0; n < 2; ++n)
#pragma unroll
                    for (int j = 0; j < 4; ++j) { const float a = acc[ai][0][m][n][j], b = acc[ai][1][m][n][j]; o[n * 4 + j] = a * __builtin_amdgcn_rcpf(1.0f + __expf(-a)) * b; }
                u32x4 w; w.x = cvt_pk_bf16(o[0], o[1]); w.y = cvt_pk_bf16(o[2], o[3]); w.z = cvt_pk_bf16(o[4], o[5]); w.w = cvt_pk_bf16(o[6], o[7]);
                *(u32x4*)rowp = w; }
    }
};
struct EpiSwiglu8 {
    static constexpr bool PERM = true, AFTER_DRAIN = false;
    unsigned char* O; int ldc;
    __device__ __forceinline__ void operator()(const f32x4 (&acc)[2][2][4][2], const Unit& u, int wr, int wc, int fr, int fq) const {
        const int row0 = u.pm * BM + wr * 64 + fr, col0 = u.pn * HALF + wc * 32 + 8 * fq;
#pragma unroll
        for (int ai = 0; ai < 2; ++ai)
#pragma unroll
            for (int m = 0; m < 4; ++m) { unsigned char* rowp = O + (size_t)(row0 + ai * HALF + m * 16) * ldc + col0;
                float o[8];
#pragma unroll
                for (int n = 0; n < 2; ++n)
#pragma unroll
                    for (int j = 0; j < 4; ++j) { const float a = acc[ai][0][m][n][j], b = acc[ai][1][m][n][j]; o[n * 4 + j] = a * __builtin_amdgcn_rcpf(1.0f + __expf(-a)) * b; }
                u32x2 w; w.x = cvt4_fp8(o[0], o[1], o[2], o[3]); w.y = cvt4_fp8(o[4], o[5], o[6], o[7]);
                *(u32x2*)rowp = w; }
    }
};
struct EpiResid {
    static constexpr bool PERM = false, AFTER_DRAIN = false;
    const float* res_lat; const float* res_ctx; float* X; const float* gate;
    __device__ __forceinline__ void operator()(const f32x4 (&acc)[2][2][4][2], const Unit& u, int wr, int wc, int fr, int fq) const {
        const int row0 = u.pm * BM + wr * 64 + fr, col0 = u.pn * BM + wc * 32 + 4 * fq;
        const int ci = u.pm < 32 ? (u.pm >> 3) : 4;
        const float* gp = gate + (size_t)ci * MODW + col0;
        f32x4 gv[2][2];
#pragma unroll
        for (int bj = 0; bj < 2; ++bj)
#pragma unroll
            for (int n = 0; n < 2; ++n) gv[bj][n] = *(const f32x4*)(gp + bj * HALF + n * 16);
#pragma unroll
        for (int ai = 0; ai < 2; ++ai)
#pragma unroll
            for (int m = 0; m < 4; ++m) { const int r = row0 + ai * HALF + m * 16;
                const float* rp = (r < NLAT ? res_lat + (size_t)r * D : res_ctx + (size_t)(r - NLAT) * D) + col0; float* xp = X + (size_t)r * D + col0;
#pragma unroll
                for (int bj = 0; bj < 2; ++bj)
#pragma unroll
                    for (int n = 0; n < 2; ++n) { const f32x4 rv = *(const f32x4*)(rp + bj * HALF + n * 16); *(f32x4*)(xp + bj * HALF + n * 16) = rv + gv[bj][n] * acc[ai][bj][m][n]; } }
    }
};
struct EpiF32 {
    static constexpr bool PERM = false, AFTER_DRAIN = false;
    float* C; int ldc;
    __device__ __forceinline__ void operator()(const f32x4 (&acc)[2][2][4][2], const Unit& u, int wr, int wc, int fr, int fq) const {
        const int row0 = u.pm * BM + wr * 64 + fr, col0 = u.pn * BM + wc * 32 + 4 * fq;
#pragma unroll
        for (int ai = 0; ai < 2; ++ai)
#pragma unroll
            for (int m = 0; m < 4; ++m) { float* rowp = C + (size_t)(row0 + ai * HALF + m * 16) * ldc + col0;
#pragma unroll
                for (int bj = 0; bj < 2; ++bj)
#pragma unroll
                    for (int n = 0; n < 2; ++n) *(f32x4*)(rowp + bj * HALF + n * 16) = acc[ai][bj][m][n]; }
    }
};

struct EpiPart {
    static constexpr bool PERM = false, AFTER_DRAIN = false;
    float* C; int ldc; int pm0; size_t slab;
    __device__ __forceinline__ void operator()(const f32x4 (&acc)[2][2][4][2], const Unit& u, int wr, int wc, int fr, int fq) const {
        const int row0 = (u.pm - pm0) * BM + wr * 64 + fr, col0 = u.pn * BM + wc * 32 + 4 * fq;
        float* base = C + (size_t)u.ks * slab;
#pragma unroll
        for (int ai = 0; ai < 2; ++ai)
#pragma unroll
            for (int m = 0; m < 4; ++m) { float* rowp = base + (size_t)(row0 + ai * HALF + m * 16) * ldc + col0;
#pragma unroll
                for (int bj = 0; bj < 2; ++bj)
#pragma unroll
                    for (int n = 0; n < 2; ++n) *(f32x4*)(rowp + bj * HALF + n * 16) = acc[ai][bj][m][n]; }
    }
};
template <class Epi, class Sched, bool ALIGN_EPI = true, bool SP2 = true, bool FP8 = false>
__device__ __forceinline__ void gemm_phase(PG8_LAS unsigned char* lds, const int tid, const Gemm g, const Sched& S, const Epi& E) {
    const int wid = __builtin_amdgcn_readfirstlane(tid >> 6), lane = tid & 63, wr = wid >> 2, wc = wid & 3, fr = lane & 15, fq = lane >> 4;
    const int K = g.ld, nt = g.K / BK;
    unsigned voffA[2], voffB[2];
#pragma unroll
    for (int i = 0; i < 2; ++i) { int R, C; stage_rc(tid * 16 + i * 8192, R, C); const int Rb = Epi::PERM ? ((R & ~31) + perm32(R & 31)) : R;
        voffA[i] = (unsigned)(R * K + C) * 2u; voffB[i] = (unsigned)(Rb * K + C) * 2u; }
    const size_t kstep = (size_t)(BK * 2);
    const size_t hstep = (size_t)HALF * K * 2;
    const size_t tstep = 2 * hstep;
    const unsigned ldsw = (unsigned)wid * 1024u;
    const int aoff = FP8 ? lds_byte(wr * 64 + fr, fq * 16) : lds_byte(wr * 64 + fr, fq * 8), boff = FP8 ? lds_byte(wc * 32 + fr, fq * 16) : lds_byte(wc * 32 + fr, fq * 8);
#define PG8_SA(b, h) (((b) * 2 + (h)) * HTB)
#define PG8_SB(b, h) ((4 + (b) * 2 + (h)) * HTB)
#define PG8_STAGE(bufoff, gbase, voff) do { _Pragma("unroll") for (int _i = 0; _i < 2; ++_i) \
        __builtin_amdgcn_global_load_lds((const unsigned*)((const char*)(gbase) + (voff)[_i]), (PG8_LAS unsigned*)(lds + (bufoff) + ldsw + _i * 8192), 16, 0, 0); } while (0)
#define PG8_LDA(dst, b, h) do { _Pragma("unroll") for (int m = 0; m < 4; ++m) { if constexpr (FP8) dst[m] = cat8(*(const PG8_LAS bf16x8*)(lds + PG8_SA(b, h) + aoff + m * 2048), *(const PG8_LAS bf16x8*)(lds + PG8_SA(b, h) + aoff + m * 2048 + 16)); \
        else dst[m] = cat8(*(const PG8_LAS bf16x8*)(lds + PG8_SA(b, h) + aoff + m * 2048), *(const PG8_LAS bf16x8*)(lds + PG8_SA(b, h) + aoff + m * 2048 + 1024)); } } while (0)
#define PG8_LDB(dst, b, h) do { _Pragma("unroll") for (int n = 0; n < 2; ++n) { if constexpr (FP8) dst[n] = cat8(*(const PG8_LAS bf16x8*)(lds + PG8_SB(b, h) + boff + n * 2048), *(const PG8_LAS bf16x8*)(lds + PG8_SB(b, h) + boff + n * 2048 + 16)); \
        else dst[n] = cat8(*(const PG8_LAS bf16x8*)(lds + PG8_SB(b, h) + boff + n * 2048), *(const PG8_LAS bf16x8*)(lds + PG8_SB(b, h) + boff + n * 2048 + 1024)); } } while (0)
#define PG8_K0(x) __builtin_bit_cast(bf16x8, __builtin_shufflevector(x, x, 0, 1, 2, 3))
#define PG8_K1(x) __builtin_bit_cast(bf16x8, __builtin_shufflevector(x, x, 4, 5, 6, 7))
#define PG8_MMA(ai, bj, At, Bt) do { __builtin_amdgcn_s_setprio(1); \
        if constexpr (FP8) { _Pragma("unroll") for (int m = 0; m < 4; ++m) _Pragma("unroll") for (int n = 0; n < 2; ++n) \
            asm volatile("v_mfma_scale_f32_16x16x128_f8f6f4 %0, %1, %2, %0, %3, %4 op_sel_hi:[0,0,0]" : "+v"(acc[ai][bj][m][n]) : "v"(Bt[n]), "v"(At[m]), "v"(sc_w), "v"(sc_a)); } \
        else { _Pragma("unroll") for (int m = 0; m < 4; ++m) _Pragma("unroll") for (int n = 0; n < 2; ++n) { \
            acc[ai][bj][m][n] = __builtin_amdgcn_mfma_f32_16x16x32_bf16(PG8_K0(Bt[n]), PG8_K0(At[m]), acc[ai][bj][m][n], 0, 0, 0); \
            acc[ai][bj][m][n] = __builtin_amdgcn_mfma_f32_16x16x32_bf16(PG8_K1(Bt[n]), PG8_K1(At[m]), acc[ai][bj][m][n], 0, 0, 0); } } \
        __builtin_amdgcn_s_setprio(0); } while (0)
#define PG8_WAIT_V(n) asm volatile("s_waitcnt vmcnt(" #n ")" ::: "memory")
#define PG8_WAIT_L(n) asm volatile("s_waitcnt lgkmcnt(" #n ")" ::: "memory")
#define PG8_BAR __builtin_amdgcn_s_barrier()
#define PG8_SCHED __builtin_amdgcn_sched_barrier(0)
    Unit cur, nxt; int ui = 0;
    if (!S.next(0, cur)) return;
    f32x4 acc[2][2][4][2];
#pragma unroll
    for (int a = 0; a < 2; ++a)
#pragma unroll
        for (int b = 0; b < 2; ++b)
#pragma unroll
            for (int m = 0; m < 4; ++m)
#pragma unroll
                for (int n = 0; n < 2; ++n) acc[a][b][m][n] = (f32x4){0.f, 0.f, 0.f, 0.f};
    i32x8 At[4], B0[2], B1[2];
    const int sc_w = 0x79797979, sc_a = 0x7f7f7f7f; (void)sc_w; (void)sc_a;
    const char* cA = (const char*)g.A + (size_t)cur.pm * tstep + cur.koff; const char* cB = (const char*)g.Bt + (size_t)cur.pb * tstep + cur.koff;
    S.a_ready(cur);
    if constexpr (SP2) {
        PG8_STAGE(PG8_SB(0, 0), cB, voffB); PG8_STAGE(PG8_SB(0, 1), cB + hstep, voffB); PG8_STAGE(PG8_SA(0, 0), cA, voffA); PG8_STAGE(PG8_SA(0, 1), cA + hstep, voffA);
        if (wr == 1) PG8_BAR;
        PG8_WAIT_V(2); PG8_BAR;
        PG8_STAGE(PG8_SB(1, 0), cB + kstep, voffB); PG8_STAGE(PG8_SA(1, 0), cA + kstep, voffA); PG8_STAGE(PG8_SB(1, 1), cB + hstep + kstep, voffB);
        PG8_WAIT_V(6); PG8_BAR;
    } else {
        PG8_STAGE(PG8_SB(0, 0), cB, voffB); PG8_STAGE(PG8_SA(0, 0), cA, voffA); PG8_STAGE(PG8_SB(0, 1), cB + hstep, voffB); PG8_STAGE(PG8_SA(0, 1), cA + hstep, voffA);
        if (wr == 1) PG8_BAR;
        PG8_WAIT_V(4); PG8_BAR;
        PG8_STAGE(PG8_SB(1, 0), cB + kstep, voffB); PG8_STAGE(PG8_SA(1, 0), cA + kstep, voffA); PG8_STAGE(PG8_SB(1, 1), cB + hstep + kstep, voffB);
        PG8_WAIT_V(6); PG8_BAR;
    }
    for (;;) {
        const bool has_next = S.next(ui + 1, nxt);
        const char* nA = has_next ? (const char*)g.A + (size_t)nxt.pm * tstep + nxt.koff : cA; const char* nB = has_next ? (const char*)g.Bt + (size_t)nxt.pb * tstep + nxt.koff : cB;
        for (int t = 0; t < nt; t += 2) {
            const bool last = (t == nt - 2);
            const char* a1 = cA + (size_t)(t + 1) * kstep;
            const char* a2 = last ? nA : cA + (size_t)(t + 2) * kstep; const char* b2 = last ? nB : cB + (size_t)(t + 2) * kstep;
            const char* a3 = a2 + kstep; const char* b3 = b2 + kstep;
            if (last && has_next) S.a_ready(nxt);
            if constexpr (SP2) {
            PG8_LDB(B0, 0, 0); PG8_LDB(B1, 0, 1); PG8_SCHED; PG8_LDA(At, 0, 0); PG8_STAGE(PG8_SA(1, 1), a1 + hstep, voffA);
            PG8_WAIT_V(8); PG8_WAIT_L(0); PG8_BAR; PG8_MMA(0, 0, At, B0); PG8_MMA(0, 1, At, B1); PG8_BAR; PG8_SCHED;
            PG8_LDA(At, 0, 1); PG8_STAGE(PG8_SB(0, 0), b2, voffB); PG8_STAGE(PG8_SB(0, 1), b2 + hstep, voffB); PG8_STAGE(PG8_SA(0, 0), a2, voffA);
            PG8_WAIT_V(8); PG8_WAIT_L(0); PG8_BAR; PG8_MMA(1, 0, At, B0); PG8_MMA(1, 1, At, B1); PG8_BAR; PG8_SCHED;
            PG8_LDB(B0, 1, 0); PG8_LDB(B1, 1, 1); PG8_SCHED; PG8_LDA(At, 1, 0); PG8_STAGE(PG8_SA(0, 1), a2 + hstep, voffA);
            PG8_WAIT_V(8); PG8_WAIT_L(0); PG8_BAR; PG8_MMA(0, 0, At, B0); PG8_MMA(0, 1, At, B1); PG8_BAR; PG8_SCHED;
            PG8_LDA(At, 1, 1); PG8_STAGE(PG8_SB(1, 0), b3, voffB); PG8_STAGE(PG8_SB(1, 1), b3 + hstep, voffB); PG8_STAGE(PG8_SA(1, 0), a3, voffA);
            PG8_WAIT_V(8); PG8_WAIT_L(0); PG8_BAR; PG8_MMA(1, 0, At, B0); PG8_MMA(1, 1, At, B1); PG8_BAR; PG8_SCHED;
            } else {
            PG8_LDB(B0, 0, 0); PG8_SCHED; PG8_LDA(At, 0, 0); PG8_STAGE(PG8_SA(1, 1), a1 + hstep, voffA);
            PG8_WAIT_L(8); PG8_BAR; PG8_WAIT_L(0); PG8_MMA(0, 0, At, B0); PG8_BAR; PG8_SCHED;
            PG8_LDB(B1, 0, 1); PG8_STAGE(PG8_SB(0, 0), b2, voffB);
            PG8_BAR; PG8_WAIT_L(0); PG8_MMA(0, 1, At, B1); PG8_BAR;
            PG8_LDA(At, 0, 1); PG8_STAGE(PG8_SA(0, 0), a2, voffA);
            PG8_BAR; PG8_WAIT_L(0); PG8_MMA(1, 0, At, B0); PG8_BAR; PG8_SCHED;
            PG8_STAGE(PG8_SB(0, 1), b2 + hstep, voffB);
            PG8_WAIT_V(6); PG8_BAR; PG8_MMA(1, 1, At, B1); PG8_BAR;
            PG8_LDB(B0, 1, 0); PG8_SCHED; PG8_LDA(At, 1, 0); PG8_STAGE(PG8_SA(0, 1), a2 + hstep, voffA);
            PG8_WAIT_L(8); PG8_BAR; PG8_WAIT_L(0); PG8_MMA(0, 0, At, B0); PG8_BAR; PG8_SCHED;
            PG8_LDB(B1, 1, 1); PG8_STAGE(PG8_SB(1, 0), b3, voffB);
            PG8_BAR; PG8_WAIT_L(0); PG8_MMA(0, 1, At, B1); PG8_BAR;
            PG8_LDA(At, 1, 1); PG8_STAGE(PG8_SA(1, 0), a3, voffA);
            PG8_BAR; PG8_WAIT_L(0); PG8_MMA(1, 0, At, B0); PG8_BAR; PG8_SCHED;
            PG8_STAGE(PG8_SB(1, 1), b3 + hstep, voffB);
            PG8_WAIT_V(6); PG8_BAR; PG8_MMA(1, 1, At, B1); PG8_BAR;
            }
        }
        if constexpr (ALIGN_EPI) { if (wr == 0) PG8_BAR; }
        if constexpr (FP8) asm volatile("s_nop 15\n\ts_nop 15" ::: "memory");
        if constexpr (!Epi::AFTER_DRAIN) { E(acc, cur, wr, wc, fr, fq); S.done(cur); }
        if (!has_next) break;
#pragma unroll
        for (int a = 0; a < 2; ++a)
#pragma unroll
            for (int b = 0; b < 2; ++b)
#pragma unroll
                for (int m = 0; m < 4; ++m)
#pragma unroll
                    for (int n = 0; n < 2; ++n) acc[a][b][m][n] = (f32x4){0.f, 0.f, 0.f, 0.f};
        cur = nxt; cA = nA; cB = nB; ++ui;
        if constexpr (ALIGN_EPI) { if (wr == 1) PG8_BAR; }
    }
    PG8_WAIT_V(0);
    if constexpr (!ALIGN_EPI) { if (wr == 0) PG8_BAR; }
    PG8_BAR;
#undef PG8_SA
#undef PG8_SB
#undef PG8_STAGE
#undef PG8_LDA
#undef PG8_LDB
#undef PG8_K0
#undef PG8_K1
#undef PG8_MMA
#undef PG8_WAIT_V
#undef PG8_WAIT_L
#undef PG8_BAR
#undef PG8_SCHED
}
}

struct Params { const float* in[26]; float* out; unsigned char* ws; int ph_lo, ph_hi; };
enum { I_X = 0, I_C, I_CTX, I_CCTX, I_ADAW, I_ADAB, I_NMIX, I_NFFN, I_WIN, I_WOUT, I_DLAM, I_DNORM, I_RELB, I_HLB, I_HNORM, I_GW2, I_GB, I_GNORM,
       I_FW1, I_FW3, I_FW2, I_ROUTER, I_MW1, I_MW3, I_MW2, I_FNORM };

struct Frame { LAS unsigned char* lds; int tid, lane, wave, G, bid; };
typedef const __attribute__((address_space(4))) Params* KP;
__device__ __forceinline__ KP launder_kp(KP k) { asm volatile("" : "+s"(k)); return k; }
__device__ __forceinline__ Frame make_frame(LAS unsigned char* lds) {
    Frame F; F.lds = lds; int t = threadIdx.x; asm volatile("" : "+v"(t)); F.tid = t; F.lane = t & 63; F.wave = __builtin_amdgcn_readfirstlane(t >> 6); F.G = gridDim.x; F.bid = blockIdx.x; return F;
}

__device__ __forceinline__ int row_ci(int m) { return m < NLAT ? (m >> 11) : 4; }

struct CvDesc { const float* src; unsigned char* dst; int nsrc, pitch, out8; };
__device__ __forceinline__ CvDesc conv_desc(const float* W0, const float* W1, int K, int Nsrc, void* WT, int Ndst, int type, int item, int out8, int lane) {
    const int nblk = Ndst / 128, kb = item / nblk, nb = item % nblk, n0 = 128 * nb, k0 = 64 * kb;
    const float* W = W0; int sc = n0;
    if (type == 1) sc = n0 < Z_SRC ? n0 : n0 + 32;
    if (type == 2) { W = (nb & 1) ? W1 : W0; sc = 128 * (nb >> 1); }
    CvDesc d; d.src = W + (size_t)(k0 + 32 * (lane >> 5)) * Nsrc + sc + 4 * (lane & 31); d.nsrc = Nsrc; d.out8 = out8;
    d.pitch = out8 ? K : 2 * K; d.dst = (unsigned char*)WT + (size_t)n0 * d.pitch + (out8 ? k0 : 2 * k0);
    return d;
}
__device__ __forceinline__ void conv_ld16(const float* s, int nsrc, f32x4 (&r)[16]) {
#pragma unroll
    for (int kk = 0; kk < 16; ++kk) { r[kk] = __builtin_nontemporal_load((const f32x4*)s); s += nsrc; }
}
__device__ __forceinline__ void conv_put16(const CvDesc& d, LAS unsigned char* scr, int step, const f32x4 (&r)[16], int lane) {
    const int h = lane >> 5, c = lane & 31;
#pragma unroll
    for (int q = 0; q < 4; ++q) {
        const int rho = 32 * q + c;
        if (d.out8) { u32x4 w;
            w.x = cvt4_fp8(r[0][q] * W8_SCALE, r[1][q] * W8_SCALE, r[2][q] * W8_SCALE, r[3][q] * W8_SCALE);     w.y = cvt4_fp8(r[4][q] * W8_SCALE, r[5][q] * W8_SCALE, r[6][q] * W8_SCALE, r[7][q] * W8_SCALE);
            w.z = cvt4_fp8(r[8][q] * W8_SCALE, r[9][q] * W8_SCALE, r[10][q] * W8_SCALE, r[11][q] * W8_SCALE);   w.w = cvt4_fp8(r[12][q] * W8_SCALE, r[13][q] * W8_SCALE, r[14][q] * W8_SCALE, r[15][q] * W8_SCALE);
            *(LAS u32x4*)(scr + rho * 64 + (((2 * h + step) ^ ((rho >> 2) & 3)) * 16)) = w; }
        else { u32x4 w0, w1; const int p0 = 4 * h + 2 * step;
            w0.x = cvt_pk_bf16(r[0][q], r[1][q]); w0.y = cvt_pk_bf16(r[2][q], r[3][q]);   w0.z = cvt_pk_bf16(r[4][q], r[5][q]);   w0.w = cvt_pk_bf16(r[6][q], r[7][q]);
            w1.x = cvt_pk_bf16(r[8][q], r[9][q]); w1.y = cvt_pk_bf16(r[10][q], r[11][q]); w1.z = cvt_pk_bf16(r[12][q], r[13][q]); w1.w = cvt_pk_bf16(r[14][q], r[15][q]);
            *(LAS u32x4*)(scr + rho * 128 + ((p0 ^ (rho & 7)) * 16)) = w0; *(LAS u32x4*)(scr + rho * 128 + (((p0 + 1) ^ (rho & 7)) * 16)) = w1; }
    }
}
__device__ __forceinline__ void conv_flush(const CvDesc& d, const LAS unsigned char* scr, int lane) {
    if (d.out8) { const int j = lane & 3;
#pragma unroll
        for (int t = 0; t < 8; ++t) { const int rho = (lane >> 2) + 16 * t, n = 4 * (rho & 31) + (rho >> 5);
            const u32x4 w = *(const LAS u32x4*)(scr + rho * 64 + ((j ^ ((rho >> 2) & 3)) * 16));
            __builtin_nontemporal_store(w, (u32x4*)(d.dst + (size_t)n * d.pitch + 16 * j)); } }
    else { const int j = lane & 7;
#pragma unroll
        for (int t = 0; t < 16; ++t) { const int rho = (lane >> 3) + 8 * t, n = 4 * (rho & 31) + (rho >> 5);
            const u32x4 w = *(const LAS u32x4*)(scr + rho * 128 + ((j ^ (rho & 7)) * 16));
            __builtin_nontemporal_store(w, (u32x4*)(d.dst + (size_t)n * d.pitch + 16 * j)); } }
}
template <class DescFn>
__device__ __forceinline__ void conv_items(DescFn desc, int first, int stride, int n, LAS unsigned char* scr, int lane) {
    CvDesc d = desc(first);
    f32x4 ra[16], rb[16];
    conv_ld16(d.src, d.nsrc, ra);
    for (int t = 0; t < n; ++t) {
        const bool has = t + 1 < n;
        CvDesc nd = d; if (has) nd = desc(first + stride * (t + 1));
        conv_ld16(d.src + (size_t)16 * d.nsrc, d.nsrc, rb);
        conv_put16(d, scr, 0, ra, lane);
        if (has) conv_ld16(nd.src, nd.nsrc, ra);
        conv_put16(d, scr, 1, rb, lane);
        conv_flush(d, scr, lane);
        d = nd;
    }
}
template <int BATCH, class DescFn>
__device__ __forceinline__ void conv_queue(const Frame& F, unsigned* ctr, int limit, int total, DescFn desc) {
    volatile LAS int* slot = (volatile LAS int*)(F.lds + MISC_OFF + 128);
    __syncthreads();
    for (;;) {
        if (F.tid == 0) {
            int st = -1;
            if (__hip_atomic_load(ctr, __ATOMIC_RELAXED, __HIP_MEMORY_SCOPE_AGENT) < (unsigned)limit) st = (int)__hip_atomic_fetch_add(ctr, (unsigned)BATCH, __ATOMIC_RELAXED, __HIP_MEMORY_SCOPE_AGENT);
            *slot = st;
        }
        __syncthreads();
        const int start = *slot;
        if (start < 0 || start >= total) break;
        conv_items(desc, start + F.wave, NWAVES, BATCH / NWAVES, F.lds + F.wave * 16384, F.lane);
        __syncthreads();
    }
    __syncthreads();
}

constexpr int CV_IN = (D / 64) * (NPI / 128), CV_OUT = (D / 64) * (D / 128), CV_13 = (D / 64) * (2 * FFD / 128), CV_2 = (FFD / 64) * (D / 128),
              CV_13E = (D / 64) * (2 * FFE / 128), CV_2E = (FFE / 64) * (D / 128);
constexpr int CV_P0_ITEMS = CV_IN + CV_OUT + CV_13 + CV_2;
constexpr int CV_L1_ITEMS = CV_IN + CV_OUT;
constexpr int CV_DEF_ITEMS = CV_L1_ITEMS + NEXP * CV_13E + NEXP * CV_2E;
constexpr int FFU_GEMM_WGS = 176, CV_FFU_ITEMS = NEXP * CV_13E;
__device__ __forceinline__ CvDesc conv_p0_desc(KP p, int it, int lane) {
    unsigned char* ws = p->ws; int r = it;
    if (r < CV_IN) return conv_desc(p->in[I_WIN], nullptr, D, INW, ws + WS_WIN, NPI, 1, r, 0, lane);
    r -= CV_IN;
    if (r < CV_OUT) return conv_desc(p->in[I_WOUT], nullptr, D, D, ws + WS_WOUT, D, 0, r, 0, lane);
    r -= CV_OUT;
    if (r < CV_13) return conv_desc(p->in[I_FW1], p->in[I_FW3], D, FFD, ws + WS_W13, 2 * FFD, 2, r, (FFU_FP8) ? 1 : 0, lane);
    r -= CV_13;
    return conv_desc(p->in[I_FW2], nullptr, FFD, D, ws + WS_W2, D, 0, r, 1, lane);
}
__device__ __forceinline__ CvDesc conv_def_desc(KP p, int it, int lane) {
    unsigned char* ws = p->ws; int r = it;
    if (r < CV_IN) return conv_desc(p->in[I_WIN] + (size_t)D * INW, nullptr, D, INW, (bf16*)(ws + WS_WIN) + (size_t)NPI * D, NPI, 1, r, 0, lane);
    r -= CV_IN;
    if (r < CV_OUT) return conv_desc(p->in[I_WOUT] + (size_t)D * D, nullptr, D, D, (bf16*)(ws + WS_WOUT) + (size_t)D * D, D, 0, r, 0, lane);
    r -= CV_OUT;
    if (r < NEXP * CV_13E) { const int e = r / CV_13E; r -= e * CV_13E;
        return conv_desc(p->in[I_MW1] + (size_t)e * D * FFE, p->in[I_MW3] + (size_t)e * D * FFE, D, FFE, ws + WS_W13E + (size_t)e * 2 * FFE * D, 2 * FFE, 2, r, 1, lane); }
    r -= NEXP * CV_13E;
    { const int e = r / CV_2E; r -= e * CV_2E;
        return conv_desc(p->in[I_MW2] + (size_t)e * FFE * D, nullptr, FFE, D, ws + WS_W2E + (size_t)e * D * FFE, D, 0, r, 1, lane); }
}
__device__ __forceinline__ void conv_drain(KP p, const Frame& F, int limit) {
    const int lane = F.lane;
    conv_queue<16>(F, (unsigned*)(p->ws + WS_CTL) + CW_CONV, limit, CV_DEF_ITEMS, [&](int it) { return conv_def_desc(p, it, lane); });
}
__device__ __forceinline__ void p0_prologue(KP p, const Frame& F) {
    unsigned char* ws = p->ws;
    {
        LAS float* cond = (LAS float*)F.lds;
        LAS float* red = (LAS float*)(F.lds + 65536);
        for (int k = F.tid; k < D; k += NTHR) {
#pragma unroll
            for (int ci = 0; ci < 4; ++ci) cond[k * 8 + ci] = fsilu(p->in[I_C][ci * D + k]);
            cond[k * 8 + 4] = fsilu(p->in[I_CCTX][k]); cond[k * 8 + 5] = 0.f; cond[k * 8 + 6] = 0.f; cond[k * 8 + 7] = 0.f;
        }
        __syncthreads();
        float* MOD = (float*)(ws + WS_MOD);
        constexpr int AC = 48;
        for (int it = F.bid; it < 2 * (MODW / AC); it += F.G) {
            const int l = it / (MODW / AC), n0 = (it % (MODW / AC)) * AC;
            const bool act = F.lane < AC;
            const float* w = p->in[I_ADAW] + (size_t)l * D * MODW + n0 + (act ? F.lane : 0);
            float a0 = 0.f, a1 = 0.f, a2 = 0.f, a3 = 0.f, a4 = 0.f;
            const int kb = F.wave * 256;
            for (int k0 = kb; k0 < kb + 256; k0 += 16) {
                float wv[16];
#pragma unroll
                for (int u = 0; u < 16; ++u) wv[u] = w[(size_t)(k0 + u) * MODW];
#pragma unroll
                for (int u = 0; u < 16; ++u) { const f32x4 c4 = *(const LAS f32x4*)(cond + (k0 + u) * 8); const float c5 = cond[(k0 + u) * 8 + 4];
                    a0 += c4[0] * wv[u]; a1 += c4[1] * wv[u]; a2 += c4[2] * wv[u]; a3 += c4[3] * wv[u]; a4 += c5 * wv[u]; }
            }
            red[(F.wave * 5 + 0) * 64 + F.lane] = a0; red[(F.wave * 5 + 1) * 64 + F.lane] = a1; red[(F.wave * 5 + 2) * 64 + F.lane] = a2;
            red[(F.wave * 5 + 3) * 64 + F.lane] = a3; red[(F.wave * 5 + 4) * 64 + F.lane] = a4;
            __syncthreads();
            if (F.tid < 320) { const int ci = F.tid / 64, ln = F.tid % 64;
                if (ln < AC) { float s = p->in[I_ADAB][(size_t)l * MODW + n0 + ln];
#pragma unroll
                    for (int w8 = 0; w8 < 8; ++w8) s += red[(w8 * 5 + ci) * 64 + ln];
                    MOD[((size_t)l * 5 + ci) * MODW + n0 + ln] = s; } }
            __syncthreads();
        }
    }
    __syncthreads();
    {
        bf16* WZT = (bf16*)(ws + WS_WZT);
        for (int i = F.bid * NTHR + F.tid; i < 2 * 32 * D; i += F.G * NTHR) { const int l = i / (32 * D), r = i % (32 * D), zc = r / D, k = r % D;
            WZT[i] = (bf16)(cvt_pk_bf16(p->in[I_WIN][((size_t)l * D + k) * INW + Z_SRC + zc], 0.f) & 0xffffu); }
    }
    { const int lane = F.lane;
      conv_queue<8>(F, (unsigned*)(ws + WS_CTL) + CW_CONV0, CV_P0_ITEMS, CV_P0_ITEMS, [&](int it) { return conv_p0_desc(p, it, lane); }); }
}

template <bool ROUTE, bool OUT8 = false, int CTXP = 0>
__device__ __forceinline__ void norm_phase(KP p, const Frame& F, int l, bool first_layer_src, const float* gain, int shift_chunk, int scale_chunk, int nrows) {
    unsigned char* ws = p->ws;
    const float* MOD = (const float*)(ws + WS_MOD) + (size_t)l * 5 * MODW;
    const float* X = (const float*)(ws + WS_X);
    bf16* H = (bf16*)(ws + WS_H);
    const int gw = F.bid * NWAVES + F.wave, NGW = F.G * NWAVES;
    volatile LAS unsigned* rcnt = (volatile LAS unsigned*)(F.lds + MISC_OFF + 512);
    if constexpr (ROUTE) {
        if (F.tid < 8) rcnt[F.tid] = 0u;
        const f32x4* rsrc = (const f32x4*)p->in[I_ROUTER]; LAS f32x4* rdst = (LAS f32x4*)F.lds;
        for (int i = F.tid; i < D * 8 / 4; i += NTHR) rdst[i] = rsrc[i];
        __syncthreads(); }
    for (int m = gw; m < nrows; m += NGW) {
        const float* src = first_layer_src ? (m < NLAT ? p->in[I_X] + (size_t)m * D : p->in[I_CTX] + (size_t)(m - NLAT) * D) : X + (size_t)m * D;
        const int ci = row_ci(m);
        const f32x4* xr = (const f32x4*)src + F.lane;
        f32x4 v[8]; float ss = 0.f;
#pragma unroll
        for (int j = 0; j < 8; ++j) v[j] = xr[64 * j];
        if (CTXP == 1 && m >= NLAT) {
            const f32x4* gq = (const f32x4*)((const float*)(ws + WS_MOD) + (size_t)(l - 1) * 5 * MODW + (size_t)4 * MODW + 5 * D) + F.lane;
            const f32x4* pp = (const f32x4*)((const float*)(ws + WS_SPLIT) + (size_t)(m - NLAT) * D) + F.lane;
#pragma unroll
            for (int j = 0; j < 8; ++j) { f32x4 a = pp[64 * j];
#pragma unroll
                for (int ks = 1; ks < FFD_KS; ++ks) a = a + pp[(size_t)ks * NCTX * D / 4 + 64 * j];
                v[j] = v[j] + gq[64 * j] * a; }
        }
        if (CTXP == 2 && m >= NLAT) {
            const f32x4* cin = (const f32x4*)(p->in[I_CTX] + (size_t)(m - NLAT) * D) + F.lane;
            const f32x4* gq = (const f32x4*)((const float*)(ws + WS_MOD) + (size_t)l * 5 * MODW + (size_t)4 * MODW + 2 * D) + F.lane;
            const f32x4* pp = (const f32x4*)((const float*)(ws + WS_SPLIT) + (size_t)(m - NLAT) * D) + F.lane;
            f32x4* xo = (f32x4*)((float*)(ws + WS_X) + (size_t)m * D) + F.lane;
#pragma unroll
            for (int j = 0; j < 8; ++j) { f32x4 a = pp[64 * j];
#pragma unroll
                for (int ks = 1; ks < OUT_KS; ++ks) a = a + pp[(size_t)ks * NCTX * D / 4 + 64 * j];
                v[j] = cin[64 * j] + gq[64 * j] * a; xo[64 * j] = v[j]; }
        }
#pragma unroll
        for (int j = 0; j < 8; ++j) ss += (v[j][0] * v[j][0] + v[j][1] * v[j][1]) + (v[j][2] * v[j][2] + v[j][3] * v[j][3]);
        const float rstd = 1.0f / sqrtf(wave_sum(ss) * (1.0f / D) + NORM_EPS);
        const f32x4* gp = (const f32x4*)gain + F.lane;
        const f32x4* shp = (const f32x4*)(MOD + (size_t)ci * MODW + shift_chunk * D) + F.lane;
        const f32x4* scp = (const f32x4*)(MOD + (size_t)ci * MODW + scale_chunk * D) + F.lane;
        u32x2* o8 = (u32x2*)(H + (size_t)m * D) + F.lane;
        unsigned* o4 = (unsigned*)((unsigned char*)H + (size_t)m * D) + F.lane;
#pragma unroll
        for (int j = 0; j < 8; ++j) { const f32x4 gg = gp[64 * j], sh = shp[64 * j], sc = scp[64 * j];
            v[j] = v[j] * rstd * gg * (sc + 1.0f) + sh;
            if (OUT8) o4[64 * j] = cvt4_fp8(v[j][0], v[j][1], v[j][2], v[j][3]);
            else { u32x2 w; w.x = cvt_pk_bf16(v[j][0], v[j][1]); w.y = cvt_pk_bf16(v[j][2], v[j][3]); o8[64 * j] = w; } }
        if constexpr (ROUTE) {
            const LAS float* rw = (const LAS float*)F.lds;
            float lg[8];
#pragma unroll
            for (int e = 0; e < 8; ++e) lg[e] = 0.f;
#pragma unroll
            for (int j = 0; j < 8; ++j)
#pragma unroll
                for (int q = 0; q < 4; ++q) { const int c = 256 * j + 4 * F.lane + q; const f32x4 r0 = *(const LAS f32x4*)(rw + c * 8), r1 = *(const LAS f32x4*)(rw + c * 8 + 4); const float y = v[j][q];
                    lg[0] += y * r0[0]; lg[1] += y * r0[1]; lg[2] += y * r0[2]; lg[3] += y * r0[3]; lg[4] += y * r1[0]; lg[5] += y * r1[1]; lg[6] += y * r1[2]; lg[7] += y * r1[3]; }
#pragma unroll
            for (int e = 0; e < 8; ++e) lg[e] = wave_sum(lg[e]);
            if (F.lane == 0) {
                int i0 = 0; float v0 = lg[0];
#pragma unroll
                for (int e = 1; e < 8; ++e) if (lg[e] > v0) { v0 = lg[e]; i0 = e; }
                int i1 = -1; float v1 = -3.0e38f;
#pragma unroll
                for (int e = 0; e < 8; ++e) if (e != i0 && lg[e] > v1) { v1 = lg[e]; i1 = e; }
                const float w0 = 1.0f / (1.0f + __expf(v1 - v0)), w1 = 1.0f - w0;
                unsigned* rt = (unsigned*)(ws + WS_ROUTE) + (size_t)m * 4;
                rt[0] = (unsigned)i0; rt[1] = (unsigned)i1; rt[2] = __float_as_uint(w0); rt[3] = __float_as_uint(w1);
                __hip_atomic_fetch_add((LAS unsigned*)(rcnt + i0), 1u, __ATOMIC_RELAXED, __HIP_MEMORY_SCOPE_WORKGROUP);
                __hip_atomic_fetch_add((LAS unsigned*)(rcnt + i1), 1u, __ATOMIC_RELAXED, __HIP_MEMORY_SCOPE_WORKGROUP);
            }
        }
    }
    if constexpr (ROUTE) { __syncthreads(); if (F.tid < 8) ((unsigned*)(ws + WS_BCNT))[(size_t)F.bid * 8 + F.tid] = rcnt[F.tid]; }
}

__device__ __forceinline__ void prep_phase(KP p, const Frame& F, int l, bool ctx_out, int parts = 15, size_t wofs = 0  ) {
    unsigned char* ws = p->ws;
    bf16* P = (bf16*)(ws + WS_P);
    const int gw = F.bid * NWAVES + F.wave, NGW = F.G * NWAVES;
    const int lane = F.lane;
    if (parts & 1) {
        const float qs = 0.17677669529663687f * LOG2E;
        float* kna = (float*)(ws + WS_KNA); float* knb = (float*)(ws + WS_KNB);
        for (int m = gw; m < MT; m += NGW) {
            bf16* row = P + (size_t)m * NPI; bf16* wrow = row + wofs;
            const int b = m < NLAT ? (m >> 11) : ((m - NLAT) >> 8);
            const int key = m < NLAT ? (CTXL + (m & (SEQ - 1))) : ((m - NLAT) & (CTXL - 1));
            if (m < NLAT) {
                const int t = m & (SEQ - 1), i = lane & 15;
                const float pos = (i < 8) ? (float)(t >> 6) : (float)(t & 63);
                const float inv = exp2f(-(float)(i & 7) * (13.287712379549449f / 8.0f));
                float sn, cs; sincosf(pos * inv, &sn, &cs);
#pragma unroll
                for (int c = 0; c < 8; ++c) {
                    const int combo = (lane >> 4) + 4 * c;
                    const int base = (combo >> 4) * 512 + (combo & 15) * 32;
                    const float x1 = bf2f(row[base + i]), x2 = bf2f(row[base + 16 + i]);
                    float y1 = x1 * cs - x2 * sn, y2 = x1 * sn + x2 * cs;
                    if (combo < 16) { y1 *= qs; y2 *= qs; }
                    const unsigned w = cvt_pk_bf16(y1, y2);
                    wrow[base + i] = (bf16)(w & 0xffffu); wrow[base + 16 + i] = (bf16)(w >> 16);
                    if (c >= 4) { float n2 = y1 * y1 + y2 * y2; n2 += __shfl_xor(n2, 1); n2 += __shfl_xor(n2, 2); n2 += __shfl_xor(n2, 4); n2 += __shfl_xor(n2, 8);
                        if (i == 0) kna[((size_t)b * 16 + (combo & 15)) * KEYS + key] = n2; }
                }
            } else {
#pragma unroll
                for (int c = 0; c < 8; ++c) { const int idx = lane + 64 * c;
                    if (ctx_out) { const unsigned w = cvt_pk_bf16(bf2f(row[idx]) * qs, 0.f); wrow[idx] = (bf16)(w & 0xffffu); }
                    const float kv = bf2f(row[512 + idx]); float n2 = kv * kv;
                    n2 += __shfl_xor(n2, 1); n2 += __shfl_xor(n2, 2); n2 += __shfl_xor(n2, 4); n2 += __shfl_xor(n2, 8); n2 += __shfl_xor(n2, 16);
                    if ((lane & 31) == 0) kna[((size_t)b * 16 + 2 * c + (lane >> 5)) * KEYS + key] = n2; }
            }
            { const u32x4 w = *(const u32x4*)(row + B_K + 8 * lane);
              float n2 = (bflo(w.x) * bflo(w.x) + bfhi(w.x) * bfhi(w.x)) + (bflo(w.y) * bflo(w.y) + bfhi(w.y) * bfhi(w.y)) + (bflo(w.z) * bflo(w.z) + bfhi(w.z) * bfhi(w.z)) + (bflo(w.w) * bflo(w.w) + bfhi(w.w) * bfhi(w.w));
              n2 += __shfl_xor(n2, 1); n2 += __shfl_xor(n2, 2); n2 += __shfl_xor(n2, 4);
              if ((lane & 7) == 0) knb[((size_t)b * 8 + (lane >> 3)) * KEYS + key] = n2; }
        }
    }
    if (parts & 2) {
        const int nitems = 2 * NB * 8 * (KEYS / 64);
        for (int it = gw; it < nitems; it += NGW) {
            const int mix = it / (NB * 8 * (KEYS / 64)); int r = it % (NB * 8 * (KEYS / 64));
            const int b = r / (8 * (KEYS / 64)); r %= 8 * (KEYS / 64); const int h = r / (KEYS / 64), kc = r % (KEYS / 64);
            const int key = kc * 64 + lane;
            const size_t srow = key < CTXL ? (size_t)(NLAT + b * CTXL + key) : (size_t)(b * SEQ + key - CTXL);
            const u32x4* src = (const u32x4*)(P + srow * NPI + (mix ? B_V : A_V) + h * 64);
            bf16* dst = (bf16*)(ws + (mix ? WS_VTB : WS_VTA)) + ((size_t)(b * 8 + h) * 64) * KEYS + key;
#pragma unroll
            for (int q = 0; q < 8; ++q) { const u32x4 w = src[q];
                dst[(size_t)(8 * q + 0) * KEYS] = (bf16)(w.x & 0xffffu); dst[(size_t)(8 * q + 1) * KEYS] = (bf16)(w.x >> 16);
                dst[(size_t)(8 * q + 2) * KEYS] = (bf16)(w.y & 0xffffu); dst[(size_t)(8 * q + 3) * KEYS] = (bf16)(w.y >> 16);
                dst[(size_t)(8 * q + 4) * KEYS] = (bf16)(w.z & 0xffffu); dst[(size_t)(8 * q + 5) * KEYS] = (bf16)(w.z >> 16);
                dst[(size_t)(8 * q + 6) * KEYS] = (bf16)(w.w & 0xffffu); dst[(size_t)(8 * q + 7) * KEYS] = (bf16)(w.w >> 16); }
        }
    }
    if (parts & 4) {
        float* HLA = (float*)(ws + WS_HLA);
        const int c0 = 8 * lane;
        float lbv[2][8];
#pragma unroll
        for (int dir = 0; dir < 2; ++dir)
#pragma unroll
            for (int j = 0; j < 8; ++j) { float lb = 0.f;
                if (l > 0) { const float h0 = p->in[I_HLB][((size_t)dir * 2 + 0) * 512 + c0 + j], h1 = p->in[I_HLB][((size_t)dir * 2 + 1) * 512 + c0 + j]; lb = fminf(fmaxf(1.0f / (1.0f + __expf(h0 - h1)), 0.f), 1.0f - 1e-6f); }
                lbv[dir][j] = lb; }
        auto gates = [&](bf16* wrow, int m, u32x4 wq, u32x4 wf0, u32x4 wf1) {
            { float x[8] = {bflo(wq.x), bfhi(wq.x), bflo(wq.y), bfhi(wq.y), bflo(wq.z), bfhi(wq.z), bflo(wq.w), bfhi(wq.w)};
#pragma unroll
              for (int j = 0; j < 8; ++j) x[j] = fsilu(x[j]);
              u32x4 w; w.x = cvt_pk_bf16(x[0], x[1]); w.y = cvt_pk_bf16(x[2], x[3]); w.z = cvt_pk_bf16(x[4], x[5]); w.w = cvt_pk_bf16(x[6], x[7]); *(u32x4*)(wrow + C_Q + c0) = w; }
#pragma unroll
            for (int dir = 0; dir < 2; ++dir) {
                const int fcol = (dir ? C_FB : C_FF) + c0;
                u32x4 w = dir ? wf1 : wf0; float x[8] = {bflo(w.x), bfhi(w.x), bflo(w.y), bfhi(w.y), bflo(w.z), bfhi(w.z), bflo(w.w), bfhi(w.w)};
                float la[8], kk[8];
#pragma unroll
                for (int j = 0; j < 8; ++j) {
                    const float lb = lbv[dir][j];
                    const float sg = fsigmoid(x[j]); const float a = lb + (1.0f - lb) * sg;
                    la[j] = fmaxf(__logf(a), -60.0f); kk[j] = (1.0f - lb) * (1.0f - sg);
                }
                w.x = cvt_pk_bf16(kk[0], kk[1]); w.y = cvt_pk_bf16(kk[2], kk[3]); w.z = cvt_pk_bf16(kk[4], kk[5]); w.w = cvt_pk_bf16(kk[6], kk[7]); *(u32x4*)(wrow + fcol) = w;
                float* hp = HLA + ((size_t)dir * MT + m) * 512 + c0;
                *(f32x4*)hp = (f32x4){la[0], la[1], la[2], la[3]}; *(f32x4*)(hp + 4) = (f32x4){la[4], la[5], la[6], la[7]};
            } };
        for (int m = gw; m < MT; m += 2 * NGW) {
            const int mb = m + NGW; const bool hasb = mb < MT;
            bf16* rowa = P + (size_t)m * NPI; bf16* rowb = P + (size_t)(hasb ? mb : m) * NPI;
            const u32x4 qa = *(const u32x4*)(rowa + C_Q + c0), fa0 = *(const u32x4*)(rowa + C_FF + c0), fa1 = *(const u32x4*)(rowa + C_FB + c0);
            const u32x4 qb = *(const u32x4*)(rowb + C_Q + c0), fb0 = *(const u32x4*)(rowb + C_FF + c0), fb1 = *(const u32x4*)(rowb + C_FB + c0);
            gates(rowa + wofs, m, qa, fa0, fa1);
            if (hasb) gates(rowb + wofs, mb, qb, fb0, fb1);
        }
    }
    if (parts & 8) {
        const bf16* H = (const bf16*)(ws + WS_H);
        const bf16* WZT = (const bf16*)(ws + WS_WZT) + (size_t)l * 32 * D;
        const int fr = lane & 15, g = lane >> 4;
        const int nit = (MT / 16 - F.bid + F.G - 1) / F.G;
        LAS float* part = (LAS float*)F.lds;
        LAS float* zfin = (LAS float*)(F.lds + 3 * 16384);
        for (int j = 0; j < nit; ++j) {
            const int row0 = (F.bid + j * F.G) * 16;
            f32x4 a0 = {0.f, 0.f, 0.f, 0.f}, a1 = {0.f, 0.f, 0.f, 0.f};
            const bf16* hp = H + (size_t)(row0 + fr) * D + 8 * g + F.wave * 256; const bf16* w0 = WZT + (size_t)fr * D + 8 * g + F.wave * 256; const bf16* w1 = WZT + (size_t)(16 + fr) * D + 8 * g + F.wave * 256;
#pragma unroll
            for (int ks = 0; ks < 8; ++ks) {
                const bf16x8 av = *(const bf16x8*)(hp + ks * 32), b0 = *(const bf16x8*)(w0 + ks * 32), b1 = *(const bf16x8*)(w1 + ks * 32);
                a0 = __builtin_amdgcn_mfma_f32_16x16x32_bf16(av, b0, a0, 0, 0, 0);
                a1 = __builtin_amdgcn_mfma_f32_16x16x32_bf16(av, b1, a1, 0, 0, 0);
            }
            LAS float* zt = part + (j * 8 + F.wave) * 512;
#pragma unroll
            for (int r = 0; r < 4; ++r) { zt[(4 * g + r) * 32 + fr] = a0[r]; zt[(4 * g + r) * 32 + 16 + fr] = a1[r]; }
        }
        __syncthreads();
        for (int j = 0; j < nit; ++j) { float sacc = 0.f;
#pragma unroll
            for (int w = 0; w < 8; ++w) sacc += part[(j * 8 + w) * 512 + F.tid];
            zfin[j * 512 + F.tid] = sacc; }
        __syncthreads();
        float* LG = (float*)(ws + WS_LG);
        { const int e = F.wave, dir = e >> 2, c = lane + 64 * (e & 3);
          const float* w2 = p->in[I_GW2] + ((size_t)(l * 2 + dir) * 16) * 256 + c;
          float wv[16];
#pragma unroll
          for (int r = 0; r < 16; ++r) wv[r] = w2[(size_t)r * 256];
          const float bias = p->in[I_GB][(size_t)(l * 2 + dir) * 256 + c];
          for (int j = 0; j < nit; ++j) {
            const int row0 = (F.bid + j * F.G) * 16; const LAS float* zt = zfin + j * 512;
#pragma unroll 4
            for (int rr = 0; rr < 16; ++rr) {
                const LAS f32x4* zr = (const LAS f32x4*)(zt + rr * 32 + dir * 16);
                const f32x4 z0 = zr[0], z1 = zr[1], z2 = zr[2], z3 = zr[3];
                float pre = bias;
#pragma unroll
                for (int q = 0; q < 4; ++q) pre += z0[q] * wv[q] + z1[q] * wv[4 + q] + z2[q] * wv[8 + q] + z3[q] * wv[12 + q];
                const float lsg = fminf(pre, 0.f) - __logf(1.0f + __expf(-fabsf(pre)));
                LG[((size_t)dir * MT + row0 + rr) * 256 + c] = lsg * (1.0f / 16.0f);
            } } }
        __syncthreads();
    }
}

constexpr int KV_PITCH = 144, KV_BUF = 64 * KV_PITCH;
__device__ __forceinline__ void kv_load(const bf16* P, const bf16* VT, int kcol, size_t krow0, int vkey0, int tid, u32x4& kr, u32x4& vr) {
    const int row = tid >> 3, ch = tid & 7;
    kr = *(const u32x4*)(P + (krow0 + row) * NPI + kcol + ch * 8);
    vr = *(const u32x4*)(VT + (size_t)row * KEYS + vkey0 + ch * 8);
}
__device__ __forceinline__ void kv_store(LAS unsigned char* kb, LAS unsigned char* vb, int tid, const u32x4& kr, const u32x4& vr) {
    const int row = tid >> 3, ch = tid & 7;
    *(LAS u32x4*)(kb + row * KV_PITCH + ch * 16) = kr; *(LAS u32x4*)(vb + row * KV_PITCH + ch * 16) = vr;
}
__device__ __forceinline__ bf16x8 v_frag(const LAS unsigned char* vb, int d, int ko, int fr, int g) {
    const LAS unsigned char* a = vb + (d * 16 + fr) * KV_PITCH + (ko + 4 * g) * 2;
    const u32x2 lo = *(const LAS u32x2*)a, hi = *(const LAS u32x2*)(a + 32);
    u32x4 w; w.x = lo.x; w.y = lo.y; w.z = hi.x; w.w = hi.y; return __builtin_bit_cast(bf16x8, w);
}

__device__ __forceinline__ float block_max(const float* v, int n, const Frame& F, volatile LAS float* red) {
    float mxv = 0.f;
    for (int i = F.tid; i < n; i += NTHR) mxv = fmaxf(mxv, v[i]);
#pragma unroll
    for (int o = 1; o < 64; o <<= 1) mxv = fmaxf(mxv, __shfl_xor(mxv, o));
    __syncthreads();
    if (F.lane == 0) red[F.wave] = mxv;
    __syncthreads();
    float r = red[0];
#pragma unroll
    for (int w8 = 1; w8 < 8; ++w8) r = fmaxf(r, red[w8]);
    return r;
}
__device__ __forceinline__ void diffattn_block(const bf16* P, const bf16* VTA, bf16* MIX, const Frame& F, int b, int h, int qrow_blk, int ntiles, float lam, float oscale, const float* normg, const float* kn  , int nkeys) {
    const int lane = F.lane, fr = lane & 15, g = lane >> 4, tid = F.tid;
    const int q0row = qrow_blk + 32 * F.wave;
    LAS unsigned char* lds = F.lds;
    bf16x8 qf[2][2];
#pragma unroll
    for (int m = 0; m < 2; ++m)
#pragma unroll
        for (int qt = 0; qt < 2; ++qt) qf[m][qt] = *(const bf16x8*)(P + (size_t)(q0row + qt * 16 + fr) * NPI + A_Q + h * 64 + m * 32 + 8 * g);
    volatile LAS float* red = (volatile LAS float*)(lds + MISC_OFF + 192);
    float kmax2[2];
#pragma unroll
    for (int m = 0; m < 2; ++m) kmax2[m] = block_max(kn + (size_t)(2 * h + m) * KEYS, nkeys, F, red);
    f32x4 O[2][2][4]; float mx[2][2], ls[2][2];
#pragma unroll
    for (int m = 0; m < 2; ++m)
#pragma unroll
        for (int qt = 0; qt < 2; ++qt) { ls[m][qt] = 0.f;
            float qn2 = 0.f;
#pragma unroll
            for (int j = 0; j < 8; ++j) { const float qv = bf2f((bf16)qf[m][qt][j]); qn2 += qv * qv; }
            qn2 = xsum32(xsum16(qn2));
            mx[m][qt] = sqrtf(qn2 * kmax2[m]);
#pragma unroll
            for (int d = 0; d < 4; ++d) O[m][qt][d] = (f32x4){0.f, 0.f, 0.f, 0.f}; }
    const bf16* vt = VTA + ((size_t)(b * 8 + h) * 64) * KEYS;
    const f32x4 zero = {0.f, 0.f, 0.f, 0.f};
    u32x4 kreg, vreg;
#define DA_TILE_LOAD(t) do { const int key0_ = (t) * 64; const size_t krow0_ = key0_ < CTXL ? (size_t)(NLAT + b * CTXL + key0_) : (size_t)(b * SEQ + key0_ - CTXL); \
        kv_load(P, vt, A_K + h * 64, krow0_, key0_, tid, kreg, vreg); } while (0)
    DA_TILE_LOAD(0);
    for (int t = 0; t < ntiles; ++t) {
        LAS unsigned char* kb = lds + (t & 1) * 2 * KV_BUF; LAS unsigned char* vb = kb + KV_BUF;
        kv_store(kb, vb, tid, kreg, vreg);
        __syncthreads();
        if (t + 1 < ntiles) DA_TILE_LOAD(t + 1);
#pragma unroll
        for (int st = 0; st < 2; ++st) {
            const int ko = 32 * st;
            bf16x8 kf[2][2], vf[4];
#pragma unroll
            for (int m = 0; m < 2; ++m)
#pragma unroll
                for (int kt = 0; kt < 2; ++kt) kf[m][kt] = *(const LAS bf16x8*)(kb + (ko + kt * 16 + fr) * KV_PITCH + (m * 32 + 8 * g) * 2);
#pragma unroll
            for (int d = 0; d < 4; ++d) vf[d] = v_frag(vb, d, ko, fr, g);
            bf16x8 pb[2][2];
#pragma unroll
            for (int m = 0; m < 2; ++m) {
                f32x4 sc[2][2];
#pragma unroll
                for (int qt = 0; qt < 2; ++qt) { const float nb = -mx[m][qt]; const f32x4 c0 = {nb, nb, nb, nb};
#pragma unroll
                    for (int kt = 0; kt < 2; ++kt) sc[qt][kt] = __builtin_amdgcn_mfma_f32_16x16x32_bf16(kf[m][kt], qf[m][qt], c0, 0, 0, 0); }
                __builtin_amdgcn_sched_barrier(0);
#pragma unroll
                for (int qt = 0; qt < 2; ++qt) {
                    const f32x4 s0 = sc[qt][0], s1 = sc[qt][1];
                    const float p0 = fexp2(s0[0]), p1 = fexp2(s0[1]), p2 = fexp2(s0[2]), p3 = fexp2(s0[3]);
                    const float p4 = fexp2(s1[0]), p5 = fexp2(s1[1]), p6 = fexp2(s1[2]), p7 = fexp2(s1[3]);
                    ls[m][qt] += ((p0 + p1) + (p2 + p3)) + ((p4 + p5) + (p6 + p7));
                    u32x4 pw; pw.x = cvt_pk_bf16(p0, p1); pw.y = cvt_pk_bf16(p2, p3); pw.z = cvt_pk_bf16(p4, p5); pw.w = cvt_pk_bf16(p6, p7);
                    pb[m][qt] = __builtin_bit_cast(bf16x8, pw);
                }
                __builtin_amdgcn_sched_barrier(0);
            }
#pragma unroll
            for (int m = 0; m < 2; ++m)
#pragma unroll
                for (int qt = 0; qt < 2; ++qt)
#pragma unroll
                    for (int d = 0; d < 4; ++d) O[m][qt][d] = __builtin_amdgcn_mfma_f32_16x16x32_bf16(vf[d], pb[m][qt], O[m][qt][d], 0, 0, 0);
            __builtin_amdgcn_sched_barrier(0);
        }
    }
#undef DA_TILE_LOAD
#pragma unroll
    for (int qt = 0; qt < 2; ++qt) {
        const float l0 = xsum32(xsum16(ls[0][qt]));
        const float l1 = xsum32(xsum16(ls[1][qt]));
        const float i0 = 1.0f / l0, i1 = lam / l1;
        f32x4 o[4]; float ss = 0.f;
#pragma unroll
        for (int d = 0; d < 4; ++d) { o[d] = O[0][qt][d] * i0 - O[1][qt][d] * i1; ss += (o[d][0] * o[d][0] + o[d][1] * o[d][1]) + (o[d][2] * o[d][2] + o[d][3] * o[d][3]); }
        ss = xsum32(xsum16(ss));
        const float rs = oscale / sqrtf(ss * (1.0f / 64.0f) + NORM_EPS);
        bf16* op = MIX + (size_t)(q0row + qt * 16 + fr) * D + h * 64 + 4 * g;
#pragma unroll
        for (int d = 0; d < 4; ++d) { const f32x4 gn = *(const f32x4*)(normg + d * 16 + 4 * g); const f32x4 r = o[d] * rs * gn;
            u32x2 w; w.x = cvt_pk_bf16(r[0], r[1]); w.y = cvt_pk_bf16(r[2], r[3]); *(u32x2*)(op + d * 16) = w; }
    }
    __syncthreads();
}

template <bool IS_CTX>
__device__ __forceinline__ void na_block(const bf16* P, const bf16* VTB, bf16* MIX, const float* relb, const Frame& F, int b, int h, int blk, const float* kn  ) {
    const int lane = F.lane, fr = lane & 15, g = lane >> 4, tid = F.tid, w = F.wave;
    LAS unsigned char* lds = F.lds;
    const int r = IS_CTX ? 0 : 2 * blk + (w >> 2), qt = w & 3;
    const int cq = IS_CTX ? (blk * 128 + 16 * w + fr) : (16 * qt + fr);
    const int qrow = IS_CTX ? (NLAT + b * CTXL + cq) : (b * SEQ + r * 64 + cq);
    const float SC = 0.125f * LOG2E;
    bf16x8 qf[2];
#pragma unroll
    for (int ks = 0; ks < 2; ++ks) { const u32x4 qw = *(const u32x4*)(P + (size_t)qrow * NPI + B_Q + h * 64 + ks * 32 + 8 * g);
        u32x4 o; o.x = cvt_pk_bf16(bflo(qw.x) * SC, bfhi(qw.x) * SC); o.y = cvt_pk_bf16(bflo(qw.y) * SC, bfhi(qw.y) * SC); o.z = cvt_pk_bf16(bflo(qw.z) * SC, bfhi(qw.z) * SC); o.w = cvt_pk_bf16(bflo(qw.w) * SC, bfhi(qw.w) * SC);
        qf[ks] = __builtin_bit_cast(bf16x8, o); }
    LAS float* biasl = (LAS float*)(lds + 4 * KV_BUF);
    if (!IS_CTX) { if (tid < 15 * 31) biasl[tid] = relb[h * 465 + tid] * LOG2E; }
    const int wlo = qt == 0 ? 0 : (qt == 1 ? 8 : (qt == 2 ? 24 : 32));
    const int rs = min(max(r - 4, 0), 24), cs = min(max(cq - 8, 0), 48);
    const int klo = IS_CTX ? 0 : min(max(2 * blk - 4, 0), 24), khi = IS_CTX ? -1 : (min(max(2 * blk + 1 - 4, 0), 24) + 7);
    const int nlat = khi - klo + 1, ntiles = nlat + 4;
    f32x4 O[4]; float ls = 0.f;
#pragma unroll
    for (int d = 0; d < 4; ++d) O[d] = (f32x4){0.f, 0.f, 0.f, 0.f};
    const bf16* vt = VTB + ((size_t)(b * 8 + h) * 64) * KEYS;
    float mx;
    { float qn2 = 0.f;
#pragma unroll
      for (int ks = 0; ks < 2; ++ks)
#pragma unroll
          for (int j = 0; j < 8; ++j) { const float qv = bf2f((bf16)qf[ks][j]); qn2 += qv * qv; }
      qn2 = xsum32(xsum16(qn2));
      float bm = 0.f;
      if (!IS_CTX) { for (int i2 = lane; i2 < 15 * 31; i2 += 64) bm = fmaxf(bm, relb[h * 465 + i2]);
#pragma unroll
          for (int o = 1; o < 64; o <<= 1) bm = fmaxf(bm, __shfl_xor(bm, o)); }
      const float kmax2 = block_max(kn, IS_CTX ? CTXL : KEYS, F, (volatile LAS float*)(lds + MISC_OFF + 192));
      mx = sqrtf(qn2 * kmax2) + bm * LOG2E; }
    const f32x4 cinit = {-mx, -mx, -mx, -mx};
    const f32x4 zero = {0.f, 0.f, 0.f, 0.f};
    u32x4 kreg, vreg;
#define NA_TILE_LOAD(t) do { const bool lat_ = (t) < nlat; const int kr_ = klo + (t), j0_ = ((t) - nlat) * 64; \
        kv_load(P, vt, B_K + h * 64, lat_ ? (size_t)(b * SEQ + kr_ * 64) : (size_t)(NLAT + b * CTXL + j0_), lat_ ? (CTXL + kr_ * 64) : j0_, tid, kreg, vreg); } while (0)
    NA_TILE_LOAD(0);
    for (int t = 0; t < ntiles; ++t) {
        LAS unsigned char* kb = lds + (t & 1) * 2 * KV_BUF; LAS unsigned char* vb = kb + KV_BUF;
        kv_store(kb, vb, tid, kreg, vreg);
        __syncthreads();
        if (t + 1 < ntiles) NA_TILE_LOAD(t + 1);
        const bool lat = t < nlat;
        const int kr = klo + t;
        if (lat && (kr < rs || kr > rs + 7)) continue;
        const int nst = lat ? 1 : 2;
        for (int st = 0; st < nst; ++st) {
            const int ko = lat ? wlo : 32 * st;
            bf16x8 kf[2][2], vf[4];
#pragma unroll
            for (int kt = 0; kt < 2; ++kt)
#pragma unroll
                for (int ks = 0; ks < 2; ++ks) kf[kt][ks] = *(const LAS bf16x8*)(kb + (ko + kt * 16 + fr) * KV_PITCH + (ks * 32 + 8 * g) * 2);
#pragma unroll
            for (int d = 0; d < 4; ++d) vf[d] = v_frag(vb, d, ko, fr, g);
            f32x4 s[2];
#pragma unroll
            for (int kt = 0; kt < 2; ++kt) { s[kt] = __builtin_amdgcn_mfma_f32_16x16x32_bf16(kf[kt][0], qf[0], cinit, 0, 0, 0); s[kt] = __builtin_amdgcn_mfma_f32_16x16x32_bf16(kf[kt][1], qf[1], s[kt], 0, 0, 0); }
            float v[8];
#pragma unroll
            for (int kt = 0; kt < 2; ++kt)
#pragma unroll
                for (int rr = 0; rr < 4; ++rr) {
                    float x = s[kt][rr];
                    if (lat) { const int ck = wlo + kt * 16 + 4 * g + rr; const bool ok = (ck >= cs) && (ck < cs + 16);
                        const int dr = kr - r + 7, dc = min(max(ck - cq + 15, 0), 30);
                        x = ok ? (x + biasl[dr * 31 + dc]) : -__builtin_inff(); }
                    v[kt * 4 + rr] = x;
                }
            float pp[8];
#pragma unroll
            for (int i = 0; i < 8; ++i) pp[i] = fexp2(v[i]);
            ls += ((pp[0] + pp[1]) + (pp[2] + pp[3])) + ((pp[4] + pp[5]) + (pp[6] + pp[7]));
            u32x4 pw; pw.x = cvt_pk_bf16(pp[0], pp[1]); pw.y = cvt_pk_bf16(pp[2], pp[3]); pw.z = cvt_pk_bf16(pp[4], pp[5]); pw.w = cvt_pk_bf16(pp[6], pp[7]);
            const bf16x8 pb = __builtin_bit_cast(bf16x8, pw);
#pragma unroll
            for (int d = 0; d < 4; ++d) O[d] = __builtin_amdgcn_mfma_f32_16x16x32_bf16(vf[d], pb, O[d], 0, 0, 0);
        }
    }
#undef NA_TILE_LOAD
    const float lt = xsum32(xsum16(ls));
    const float il = 1.0f / lt;
    bf16* op = MIX + (size_t)qrow * D + 512 + h * 64 + 4 * g;
#pragma unroll
    for (int d = 0; d < 4; ++d) { const f32x4 rr = O[d] * il; u32x2 w2; w2.x = cvt_pk_bf16(rr[0], rr[1]); w2.y = cvt_pk_bf16(rr[2], rr[3]); *(u32x2*)(op + d * 16) = w2; }
    __syncthreads();
}

__device__ __forceinline__ int pos_row(int pos, int b, int dir) {
    if (pos < CTXL) { const int j = dir ? (CTXL - 1 - pos) : pos; return NLAT + b * CTXL + j; }
    const int t = pos - CTXL; return b * SEQ + (dir ? (SEQ - 1 - t) : t);
}
template <bool HG>
__device__ __forceinline__ void cd_chunk_seq(KP p, const Frame& F, int l, bool ctx_out, int b, int h, int dir, int colhalf) {
    constexpr int DK = HG ? 128 : 64, DVL = HG ? 64 : 128, C = 64, NCH = KEYS / C;
    constexpr int PK = DK * 2 + 16, PC = 144;
    constexpr int CPT = DK / 64;
    constexpr int VPT = DVL / 64;
    constexpr int KS = DK / 32;
    constexpr int NVT = DVL / 32;
    constexpr int O_QT = 0, O_KT = O_QT + 64 * PK, O_QE = O_KT + 64 * PK, O_KD = O_QE + 64 * PK, O_VT = O_KD + DK * PC, O_PM = O_VT + DVL * PC,
                  O_ST = O_PM + 64 * PC, ST_BYTES = DVL * PK, O_SEG = O_ST + 2 * ST_BYTES, O_DEC = O_SEG + 8 * DK * 4, O_END = O_DEC + DK * 4;
    static_assert(O_END <= RING_BYTES, "cd lds");
    unsigned char* ws = p->ws;
    const bf16* P = (const bf16*)(ws + WS_P);
    const float* LA = HG ? (const float*)(ws + WS_HLA) + (size_t)dir * MT * 512 + h * 128 : (const float*)(ws + WS_LG) + (size_t)dir * MT * 256 + h * 64;
    constexpr int LAW = HG ? 512 : 256;
    float* OUT = (float*)(ws + (HG ? WS_OC : WS_OD)) + (size_t)dir * MT * 512;
    LAS unsigned char* lds = F.lds;
    const int lane = F.lane, w = F.wave, fr = lane & 15, g = lane >> 4;
    const int d0 = CPT * lane;
    const int colbase = HG ? colhalf * 64 : 0;
    const int qcol = HG ? (C_Q + h * 128 + d0) : (D_Q + h * 64 + d0);
    const int kcol = HG ? ((dir ? C_FB : C_FF) + h * 128 + d0) : (D_K + h * 64 + d0);
    const int vcol = (HG ? C_I : D_V) + h * 128 + colbase + VPT * lane;
    const float qscale = HG ? 1.0f : 0.125f;
    const int sdt = HG ? w : (w >> 1), svt0 = HG ? 0 : 4 * (w & 1);
    f32x4 Sacc[4];
#pragma unroll
    for (int t = 0; t < 4; ++t) Sacc[t] = (f32x4){0.f, 0.f, 0.f, 0.f};
    for (int i = F.tid; i < ST_BYTES / 4; i += NTHR) ((LAS unsigned*)(lds + O_ST + ST_BYTES))[i] = 0u;
    unsigned qr[8], kr[8], vr[8]; float lr[8][CPT];
#define CD_PREFETCH(cn) do { \
        _Pragma("unroll") for (int ii = 0; ii < 8; ++ii) { const size_t row = (size_t)pos_row((cn) * C + 8 * w + ii, b, dir); const bf16* pr = P + row * NPI; \
            if (CPT == 2) { qr[ii] = *(const unsigned*)(pr + qcol); kr[ii] = *(const unsigned*)(pr + kcol); const f32x2 t2 = *(const f32x2*)(LA + row * LAW + d0); lr[ii][0] = t2[0]; lr[ii][CPT - 1] = t2[1]; } \
            else { qr[ii] = pr[qcol]; kr[ii] = pr[kcol]; lr[ii][0] = LA[row * LAW + d0]; } \
            if (VPT == 2) vr[ii] = *(const unsigned*)(pr + vcol); else vr[ii] = pr[vcol]; } } while (0)
    CD_PREFETCH(0);
    __syncthreads();
    for (int c = 0; c < NCH; ++c) {
        float la[8][CPT], qq[8][CPT], kk[8][CPT]; unsigned vv[VPT][4];
        float run[CPT];
#pragma unroll
        for (int u = 0; u < CPT; ++u) run[u] = 0.f;
#pragma unroll
        for (int ii = 0; ii < 8; ++ii) {
            if (CPT == 2) { qq[ii][0] = bflo(qr[ii]); qq[ii][CPT - 1] = bfhi(qr[ii]); kk[ii][0] = bflo(kr[ii]); kk[ii][CPT - 1] = bfhi(kr[ii]); }
            else { qq[ii][0] = bflo(qr[ii]) * qscale; kk[ii][0] = bflo(kr[ii]); }
#pragma unroll
            for (int u = 0; u < CPT; ++u) { run[u] += lr[ii][u]; la[ii][u] = run[u]; }
        }
        if (VPT == 2) {
#pragma unroll
            for (int q4 = 0; q4 < 4; ++q4) { vv[0][q4] = (vr[2 * q4] & 0xffffu) | (vr[2 * q4 + 1] << 16); vv[VPT - 1][q4] = (vr[2 * q4] >> 16) | (vr[2 * q4 + 1] & 0xffff0000u); }
        } else {
#pragma unroll
            for (int q4 = 0; q4 < 4; ++q4) vv[0][q4] = (vr[2 * q4] & 0xffffu) | (vr[2 * q4 + 1] << 16);
        }
#pragma unroll
        for (int u = 0; u < CPT; ++u) ((LAS float*)(lds + O_SEG))[w * DK + d0 + u] = run[u];
        if (c + 1 < NCH) CD_PREFETCH(c + 1);
        __syncthreads();
        float off[CPT], rv[CPT], bend[CPT];
#pragma unroll
        for (int u = 0; u < CPT; ++u) { off[u] = 0.f; rv[u] = 0.f; bend[u] = 0.f; }
#pragma unroll
        for (int s2 = 0; s2 < 8; ++s2)
#pragma unroll
            for (int u = 0; u < CPT; ++u) { const float t = ((LAS float*)(lds + O_SEG))[s2 * DK + d0 + u]; off[u] += (s2 < w) ? t : 0.f; rv[u] += (s2 < 4) ? t : 0.f; bend[u] += t; }
        float erv[CPT], ebr[CPT];
#pragma unroll
        for (int u = 0; u < CPT; ++u) { erv[u] = __expf(rv[u]); ebr[u] = __expf(bend[u] - rv[u]); }
        float kdv[8][CPT];
#pragma unroll
        for (int ii = 0; ii < 8; ++ii) {
            float qt[CPT], kt[CPT], qe[CPT];
#pragma unroll
            for (int u = 0; u < CPT; ++u) { const float bi = off[u] + la[ii][u];
                const float x1 = __expf(fminf(fmaxf(bi - rv[u], -60.0f), 60.0f));
                qt[u] = qq[ii][u] * x1; kt[u] = kk[ii][u] * __builtin_amdgcn_rcpf(x1); qe[u] = qt[u] * erv[u]; kdv[ii][u] = kt[u] * ebr[u]; }
            const int i = 8 * w + ii;
            if (CPT == 2) {
                *(LAS unsigned*)(lds + O_QT + i * PK + d0 * 2) = cvt_pk_bf16(qt[0], qt[CPT - 1]);
                *(LAS unsigned*)(lds + O_KT + i * PK + d0 * 2) = cvt_pk_bf16(kt[0], kt[CPT - 1]);
                *(LAS unsigned*)(lds + O_QE + i * PK + d0 * 2) = cvt_pk_bf16(qe[0], qe[CPT - 1]);
            } else {
                *(LAS bf16*)(lds + O_QT + i * PK + d0 * 2) = (bf16)(cvt_pk_bf16(qt[0], 0.f) & 0xffffu);
                *(LAS bf16*)(lds + O_KT + i * PK + d0 * 2) = (bf16)(cvt_pk_bf16(kt[0], 0.f) & 0xffffu);
                *(LAS bf16*)(lds + O_QE + i * PK + d0 * 2) = (bf16)(cvt_pk_bf16(qe[0], 0.f) & 0xffffu);
            }
        }
#pragma unroll
        for (int u = 0; u < CPT; ++u) { u32x4 wv4; wv4.x = cvt_pk_bf16(kdv[0][u], kdv[1][u]); wv4.y = cvt_pk_bf16(kdv[2][u], kdv[3][u]); wv4.z = cvt_pk_bf16(kdv[4][u], kdv[5][u]); wv4.w = cvt_pk_bf16(kdv[6][u], kdv[7][u]);
            *(LAS u32x4*)(lds + O_KD + (d0 + u) * PC + (8 * w) * 2) = wv4; }
#pragma unroll
        for (int u = 0; u < VPT; ++u) { u32x4 wv4; wv4.x = vv[u][0]; wv4.y = vv[u][1]; wv4.z = vv[u][2]; wv4.w = vv[u][3];
            *(LAS u32x4*)(lds + O_VT + (VPT * lane + u) * PC + (8 * w) * 2) = wv4; }
        if (w == 0) {
#pragma unroll
            for (int u = 0; u < CPT; ++u) ((LAS float*)(lds + O_DEC))[d0 + u] = __expf(bend[u]);
        }
        __syncthreads();
        const LAS unsigned char* st_rd = lds + O_ST + ((c + 1) & 1) * ST_BYTES;
        LAS unsigned char* st_wr = lds + O_ST + (c & 1) * ST_BYTES;
        const bool want_out = ctx_out || c >= CTXL / C;
        if (want_out) {
            { const int it = w >> 1, jt0 = 2 * (w & 1);
              bf16x8 bq[KS], ak[2][KS];
#pragma unroll
              for (int ks = 0; ks < KS; ++ks) bq[ks] = *(const LAS bf16x8*)(lds + O_QT + (16 * it + fr) * PK + (ks * 32 + 8 * g) * 2);
#pragma unroll
              for (int t = 0; t < 2; ++t)
#pragma unroll
                  for (int ks = 0; ks < KS; ++ks) ak[t][ks] = *(const LAS bf16x8*)(lds + O_KT + (16 * (jt0 + t) + fr) * PK + (ks * 32 + 8 * g) * 2);
              __builtin_amdgcn_sched_barrier(0);
#pragma unroll
              for (int t = 0; t < 2; ++t) { const int jt = jt0 + t; f32x4 sacc = {0.f, 0.f, 0.f, 0.f};
#pragma unroll
                  for (int ks = 0; ks < KS; ++ks) sacc = __builtin_amdgcn_mfma_f32_16x16x32_bf16(ak[t][ks], bq[ks], sacc, 0, 0, 0);
                  const int i = 16 * it + fr, j0 = 16 * jt + 4 * g;
                  const float m0 = (j0 + 0 <= i) ? sacc[0] : 0.f, m1 = (j0 + 1 <= i) ? sacc[1] : 0.f, m2 = (j0 + 2 <= i) ? sacc[2] : 0.f, m3 = (j0 + 3 <= i) ? sacc[3] : 0.f;
                  u32x2 pw; pw.x = cvt_pk_bf16(m0, m1); pw.y = cvt_pk_bf16(m2, m3);
                  *(LAS u32x2*)(lds + O_PM + i * PC + j0 * 2) = pw; }
            }
            __syncthreads();
            { const int it = w >> 1;
              bf16x8 ap[2], aq[KS], bv[NVT][2], bs[NVT][KS];
#pragma unroll
              for (int ks = 0; ks < 2; ++ks) ap[ks] = *(const LAS bf16x8*)(lds + O_PM + (16 * it + fr) * PC + (ks * 32 + 8 * g) * 2);
#pragma unroll
              for (int ks = 0; ks < KS; ++ks) aq[ks] = *(const LAS bf16x8*)(lds + O_QE + (16 * it + fr) * PK + (ks * 32 + 8 * g) * 2);
#pragma unroll
              for (int t = 0; t < NVT; ++t) { const int vt = (w & 1) * NVT + t;
#pragma unroll
                  for (int ks = 0; ks < 2; ++ks) bv[t][ks] = *(const LAS bf16x8*)(lds + O_VT + (16 * vt + fr) * PC + (ks * 32 + 8 * g) * 2);
#pragma unroll
                  for (int ks = 0; ks < KS; ++ks) bs[t][ks] = *(const LAS bf16x8*)(st_rd + (16 * vt + fr) * PK + (ks * 32 + 8 * g) * 2); }
              __builtin_amdgcn_sched_barrier(0);
              f32x4 oacc[NVT];
#pragma unroll
              for (int t = 0; t < NVT; ++t) { oacc[t] = (f32x4){0.f, 0.f, 0.f, 0.f};
#pragma unroll
                  for (int ks = 0; ks < 2; ++ks) oacc[t] = __builtin_amdgcn_mfma_f32_16x16x32_bf16(ap[ks], bv[t][ks], oacc[t], 0, 0, 0);
#pragma unroll
                  for (int ks = 0; ks < KS; ++ks) oacc[t] = __builtin_amdgcn_mfma_f32_16x16x32_bf16(aq[ks], bs[t][ks], oacc[t], 0, 0, 0); }
              float* orow[4];
#pragma unroll
              for (int r = 0; r < 4; ++r) orow[r] = OUT + (size_t)pos_row(c * C + 16 * it + 4 * g + r, b, dir) * 512 + h * 128 + colbase + (w & 1) * NVT * 16 + fr;
#pragma unroll
              for (int t = 0; t < NVT; ++t)
#pragma unroll
                  for (int r = 0; r < 4; ++r) orow[r][16 * t] = oacc[t][r];
            }
        }
        { bf16x8 ak[2], bv[4][2];
#pragma unroll
          for (int ks = 0; ks < 2; ++ks) ak[ks] = *(const LAS bf16x8*)(lds + O_KD + (16 * sdt + fr) * PC + (ks * 32 + 8 * g) * 2);
          const f32x4 dec4 = *(const LAS f32x4*)(lds + O_DEC + (16 * sdt + 4 * g) * 4);
#pragma unroll
          for (int t = 0; t < 4; ++t)
#pragma unroll
              for (int ks = 0; ks < 2; ++ks) bv[t][ks] = *(const LAS bf16x8*)(lds + O_VT + (16 * (svt0 + t) + fr) * PC + (ks * 32 + 8 * g) * 2);
          __builtin_amdgcn_sched_barrier(0);
#pragma unroll
          for (int t = 0; t < 4; ++t) { const int vt = svt0 + t; Sacc[t] = Sacc[t] * dec4;
#pragma unroll
              for (int ks = 0; ks < 2; ++ks) Sacc[t] = __builtin_amdgcn_mfma_f32_16x16x32_bf16(ak[ks], bv[t][ks], Sacc[t], 0, 0, 0);
              u32x2 sw; sw.x = cvt_pk_bf16(Sacc[t][0], Sacc[t][1]); sw.y = cvt_pk_bf16(Sacc[t][2], Sacc[t][3]);
              *(LAS u32x2*)(st_wr + (16 * vt + fr) * PK + (16 * sdt + 4 * g) * 2) = sw; }
        }
    }
#undef CD_PREFETCH
    __syncthreads();
}

__device__ __forceinline__ void cd_combine_phase(KP p, const Frame& F, int l, bool ctx_out) {
    unsigned char* ws = p->ws;
    const bf16* P = (const bf16*)(ws + WS_P); bf16* MIX = (bf16*)(ws + WS_MIX);
    const int gw = F.bid * NWAVES + F.wave, NGW = F.G * NWAVES, lane = F.lane;
    const int nrows = ctx_out ? MT : NLAT;
    for (int it = gw; it < 2 * nrows; it += NGW) {
        const int mix = it / nrows, m = it % nrows;
        const float* o0 = (const float*)(ws + (mix ? WS_OD : WS_OC)) + (size_t)m * 512 + 8 * lane; const float* o1 = o0 + (size_t)MT * 512;
        const f32x4 a0 = *(const f32x4*)o0 + *(const f32x4*)o1, a1 = *(const f32x4*)(o0 + 4) + *(const f32x4*)(o1 + 4);
        float ss = (a0[0] * a0[0] + a0[1] * a0[1]) + (a0[2] * a0[2] + a0[3] * a0[3]) + (a1[0] * a1[0] + a1[1] * a1[1]) + (a1[2] * a1[2] + a1[3] * a1[3]);
        ss += __shfl_xor(ss, 1); ss += __shfl_xor(ss, 2); ss += __shfl_xor(ss, 4); ss += __shfl_xor(ss, 8);
        const float rstd = 1.0f / sqrtf(ss * (1.0f / 128.0f) + NORM_EPS);
        const float* ng = p->in[mix ? I_GNORM : I_HNORM] + (size_t)l * 128 + ((8 * lane) & 127);
        const f32x4 g0 = *(const f32x4*)ng, g1 = *(const f32x4*)(ng + 4);
        const u32x4 gw4 = *(const u32x4*)(P + (size_t)m * NPI + (mix ? D_R : C_G) + 8 * lane);
        float gt[8] = {bflo(gw4.x), bfhi(gw4.x), bflo(gw4.y), bfhi(gw4.y), bflo(gw4.z), bfhi(gw4.z), bflo(gw4.w), bfhi(gw4.w)};
        float r[8];
#pragma unroll
        for (int j = 0; j < 4; ++j) { r[j] = a0[j] * rstd * g0[j] * fsilu(gt[j]); r[4 + j] = a1[j] * rstd * g1[j] * fsilu(gt[4 + j]); }
        u32x4 w; w.x = cvt_pk_bf16(r[0], r[1]); w.y = cvt_pk_bf16(r[2], r[3]); w.z = cvt_pk_bf16(r[4], r[5]); w.w = cvt_pk_bf16(r[6], r[7]);
        *(u32x4*)(MIX + (size_t)m * D + (mix ? 1536 : 1024) + 8 * lane) = w;
    }
}

constexpr int CD_BLOCKS = 96;
__device__ __forceinline__ void cd_item(KP p, const Frame& F, int l, bool ctx_out, int it) {
    if (it < 64) { const int colhalf = it & 1, dir = (it >> 1) & 1, h = (it >> 2) & 3, b = it >> 4; cd_chunk_seq<true>(p, F, l, ctx_out, b, h, dir, colhalf); }
    else { const int i = it - 64, dir = i & 1, h = (i >> 1) & 3, b = i >> 3; cd_chunk_seq<false>(p, F, l, ctx_out, b, h, dir, 0); }
}
__device__ __forceinline__ void mixer_phase(KP p, const Frame& F, int l, bool ctx_out) {
    unsigned char* ws = p->ws;
    if (F.G >= 256) { if (F.bid < CD_BLOCKS) { cd_item(p, F, l, ctx_out, F.bid); if ((PROBE_DUP) == 31) cd_item(p, F, l, ctx_out, F.bid); } }
    else { for (int it = F.bid; it < CD_BLOCKS; it += F.G) cd_item(p, F, l, ctx_out, it); }
    const bf16* P = (const bf16*)(ws + WS_P); bf16* MIX = (bf16*)(ws + WS_MIX);
    const int x = F.bid & 7;
    unsigned* qhead = (unsigned*)(ws + WS_CTL) + CW_QUEUE + 64 * (8 * l + x);
    volatile LAS unsigned* slot = (volatile LAS unsigned*)(F.lds + MISC_OFF + 64);
    const float* lp = p->in[I_DLAM] + (size_t)l * 128;
    float s01 = 0.f, s23 = 0.f;
    for (int i = 0; i < 32; ++i) { s01 += lp[i] * lp[32 + i]; s23 += lp[64 + i] * lp[96 + i]; }
    const float li = 0.8f - 0.6f * expf(-0.3f * (float)l);
    const float lam = expf(s01) - expf(s23) + li;
    const bf16* VTA = (const bf16*)(ws + WS_VTA); const bf16* VTB = (const bf16*)(ws + WS_VTB);
    const float* ng = p->in[I_DNORM] + (size_t)l * 64;
    const float* relb = p->in[I_RELB] + (size_t)l * 8 * 15 * 31;
    const float* kna = (const float*)(ws + WS_KNA); const float* knb = (const float*)(ws + WS_KNB);
    const int perA = 8 + (ctx_out ? 1 : 0), perB = 16 + (ctx_out ? 2 : 0), nA = 4 * perA, nTot = nA + 4 * perB;
    const int nExtra = ((PROBE_DUP) == 32) ? nTot : ((PROBE_DUP) == 33) ? nA : ((PROBE_DUP) == 34) ? (nTot - nA) : 0;
    for (;;) {
        __syncthreads();
        if (F.tid == 0) *slot = atomicAdd(qhead, 1u);
        __syncthreads();
        int it = (int)*slot;
        if (it >= nTot + nExtra) break;
        if (it >= nTot) it = it - nTot + (((PROBE_DUP) == 34) ? nA : 0);
        if (it < nA) {
            const int bh = x + 8 * (it / perA), j = it % perA, b = bh >> 3, h = bh & 7;
            if (j < 8) diffattn_block(P, VTA, MIX, F, b, h, b * SEQ + j * 256, KEYS / 64, lam, 1.0f - li, ng, kna + (size_t)b * 16 * KEYS, KEYS);
            else diffattn_block(P, VTA, MIX, F, b, h, NLAT + b * CTXL, CTXL / 64, lam, 1.0f - li, ng, kna + (size_t)b * 16 * KEYS, CTXL);
        } else {
            const int i2 = it - nA, bh = x + 8 * (i2 / perB), j = i2 % perB, b = bh >> 3, h = bh & 7;
            if (j < 16) na_block<false>(P, VTB, MIX, relb, F, b, h, j, knb + ((size_t)b * 8 + h) * KEYS);
            else na_block<true>(P, VTB, MIX, relb, F, b, h, j - 16, knb + ((size_t)b * 8 + h) * KEYS);
        }
    }
}

__device__ __forceinline__ void moe_gather_phase(KP p, const Frame& F) {
    unsigned char* ws = p->ws;
    unsigned* ctl = (unsigned*)(ws + WS_CTL);
    volatile LAS int* gtot = (volatile LAS int*)(F.lds + MISC_OFF + 512);
    { const unsigned* bc = (const unsigned*)(ws + WS_BCNT); const int e = F.wave, j = F.lane;
      int v4[4]; int part = 0, mine_before = 0;
#pragma unroll
      for (int q = 0; q < 4; ++q) { const int b2 = 4 * j + q; v4[q] = b2 < F.G ? (int)bc[(size_t)b2 * 8 + e] : 0; part += v4[q]; if (b2 < F.bid) mine_before += v4[q]; }
      int incl = part;
#pragma unroll
      for (int o = 1; o < 64; o <<= 1) { const int t = __shfl_up(incl, o); if (j >= o) incl += t; }
      const int total = __shfl(incl, 63);
      const int excl = incl - part;
      const int jb = F.bid >> 2;
      const int base_e = __shfl(excl, jb) + __shfl(mine_before, jb);
      if (j == 0) { gtot[e] = total; gtot[8 + e] = base_e; gtot[16 + e] = 0; }
    }
    __syncthreads();
    int off[8], bse[8]; int tot = 0;
#pragma unroll
    for (int e = 0; e < 8; ++e) { const int c = gtot[e]; off[e] = tot; bse[e] = tot + gtot[8 + e]; tot += ((c + 255) >> 8) << 8; }
    if (F.bid == 0 && F.tid == 0) {
        ctl[CW_PANEL] = (unsigned)(tot >> 8);
#pragma unroll
        for (int e = 0; e < 8; ++e) { const int pe = (e == 7 ? tot : off[e + 1]) >> 8; for (int q = off[e] >> 8; q < pe; ++q) ctl[CW_PANEL + 1 + q] = (unsigned)e; }
    }
    const bf16* H = (const bf16*)(ws + WS_H); bf16* HS = (bf16*)(ws + WS_HS);
    const unsigned* RT = (const unsigned*)(ws + WS_ROUTE); int* POS = (int*)(ws + WS_POS);
    const int gw = F.bid * NWAVES + F.wave, NGW = F.G * NWAVES;
    for (int m = gw; m < NLAT; m += NGW) {
        const int i0 = (int)RT[(size_t)m * 4], i1 = (int)RT[(size_t)m * 4 + 1];
        int p0 = 0, p1 = 0;
        if (F.lane == 0) { p0 = (int)__hip_atomic_fetch_add((LAS int*)(gtot + 16 + i0), 1, __ATOMIC_RELAXED, __HIP_MEMORY_SCOPE_WORKGROUP); p1 = (int)__hip_atomic_fetch_add((LAS int*)(gtot + 16 + i1), 1, __ATOMIC_RELAXED, __HIP_MEMORY_SCOPE_WORKGROUP); }
        p0 = __shfl(p0, 0); p1 = __shfl(p1, 0);
        int o0 = 0, o1 = 0;
#pragma unroll
        for (int e = 0; e < 8; ++e) { o0 = (e == i0) ? bse[e] : o0; o1 = (e == i1) ? bse[e] : o1; }
        p0 += o0; p1 += o1;
        if (F.lane == 0) { POS[(size_t)m * 2] = p0; POS[(size_t)m * 2 + 1] = p1; }
        const u32x4* src = (const u32x4*)((const unsigned char*)H + (size_t)m * D) + F.lane;
        u32x4* d0 = (u32x4*)((unsigned char*)HS + (size_t)p0 * D) + F.lane; u32x4* d1 = (u32x4*)((unsigned char*)HS + (size_t)p1 * D) + F.lane;
        { const u32x4 va = src[0], vb = src[64]; d0[0] = va; d0[64] = vb; d1[0] = va; d1[64] = vb; }
    }
    __syncthreads();
}

__device__ __forceinline__ void final_phase(KP p, const Frame& F) {
    unsigned char* ws = p->ws;
    const float* X = (const float*)(ws + WS_X); const bf16* Y = (const bf16*)(ws + WS_Y);
    const float* MOD = (const float*)(ws + WS_MOD) + (size_t)1 * 5 * MODW;
    const unsigned* RT = (const unsigned*)(ws + WS_ROUTE); const int* POS = (const int*)(ws + WS_POS);
    const int gw = F.bid * NWAVES + F.wave, NGW = F.G * NWAVES;
    for (int m = gw; m < NLAT; m += NGW) {
        const int b = m >> 11;
        const float w0 = __uint_as_float(RT[(size_t)m * 4 + 2]), w1 = __uint_as_float(RT[(size_t)m * 4 + 3]);
        const int p0 = POS[(size_t)m * 2], p1 = POS[(size_t)m * 2 + 1];
        const f32x4* xr = (const f32x4*)(X + (size_t)m * D) + F.lane; const u32x2* y0 = (const u32x2*)(Y + (size_t)p0 * D) + F.lane; const u32x2* y1 = (const u32x2*)(Y + (size_t)p1 * D) + F.lane;
        const f32x4* gp = (const f32x4*)(MOD + (size_t)b * MODW + 5 * D) + F.lane;
        const int split0 = MOE_FULL_PANELS * 256;
        const f32x4* q0 = (const f32x4*)((const float*)(ws + WS_SPLIT) + (size_t)(p0 - split0) * D) + F.lane; const f32x4* q1 = (const f32x4*)((const float*)(ws + WS_SPLIT) + (size_t)(p1 - split0) * D) + F.lane;
        f32x4 v[8]; float ss = 0.f;
#pragma unroll
        for (int j = 0; j < 8; ++j) {
            f32x4 a0, a1;
            if (p0 < split0) { const u32x2 w = y0[64 * j]; a0 = (f32x4){bflo(w.x), bfhi(w.x), bflo(w.y), bfhi(w.y)}; } else { a0 = q0[64 * j];
#pragma unroll
                for (int ks = 1; ks < MOE_KS; ++ks) a0 = a0 + q0[(size_t)ks * 8 * 256 * D / 4 + 64 * j]; }
            if (p1 < split0) { const u32x2 w = y1[64 * j]; a1 = (f32x4){bflo(w.x), bfhi(w.x), bflo(w.y), bfhi(w.y)}; } else { a1 = q1[64 * j];
#pragma unroll
                for (int ks = 1; ks < MOE_KS; ++ks) a1 = a1 + q1[(size_t)ks * 8 * 256 * D / 4 + 64 * j]; }
            v[j] = xr[64 * j] + gp[64 * j] * (a0 * w0 + a1 * w1); ss += (v[j][0] * v[j][0] + v[j][1] * v[j][1]) + (v[j][2] * v[j][2] + v[j][3] * v[j][3]); }
        const float rstd = 1.0f / sqrtf(wave_sum(ss) * (1.0f / D) + NORM_EPS);
        const f32x4* fn = (const f32x4*)p->in[I_FNORM] + F.lane; f32x4* o = (f32x4*)(p->out + (size_t)m * D) + F.lane;
#pragma unroll
        for (int j = 0; j < 8; ++j) o[64 * j] = v[j] * rstd * fn[64 * j];
    }
}

constexpr int PH_L0 = 1, PH_L1 = 12, PH_END = 23;
#define GRID_BAR() do { XcdBarrier bb_; bb_.bar = (unsigned*)(launder_kp(kp0)->ws + WS_CTL) + CW_BAR; bb_.x = xb_xcc_id(); bb_.st = (volatile LAS unsigned*)(ldsb + MISC_OFF) + 8; xcd_barrier(bb_); } while (0)
#define IN(k) (lo <= (k) && (k) < hi)
#define SEAM(k) do { if (IN(k) && IN((k) + 1)) { GRID_BAR(); if ((PROBE_DUP) == 999) GRID_BAR(); } } while (0)
#define RUNPH(id, ...) do { if ((PROBE_DUP) == (id)) { { __VA_ARGS__ } GRID_BAR(); } { __VA_ARGS__ } } while (0)
#define PHASE_BEGIN() const KP p = launder_kp(kp0); const Frame F = make_frame(ldsb); unsigned char* const ws = p->ws; (void)ws

template <int l>
__device__ __forceinline__ void layer_phases(const KP kp0, LAS unsigned char* const ldsb, const int lo, const int hi) {
        const int base = l == 0 ? PH_L0 : PH_L1;
        const bool ctx_out = (l == 0);
        const int mrows = ctx_out ? MT : NLAT;
        if (IN(base + 0)) { RUNPH(10, PHASE_BEGIN(); norm_phase<false, false, (l == 1) ? 1 : 0>(p, F, l, l == 0, p->in[I_NMIX] + (size_t)l * D, 0, 1, MT); if (l == 1) conv_drain(p, F, CV_L1_ITEMS);); SEAM(base + 0); }
        if (IN(base + 1)) {
            RUNPH(1,
            PHASE_BEGIN();
            pg8::Gemm g{(const bf16*)(ws + WS_H), (const bf16*)(ws + WS_WIN) + (size_t)l * NPI * D, D, D};
            pg8::DenseOrder S; S.init(MT / 256, NPI / 256, F.G, F.bid);
            pg8::EpiBf16 E{(bf16*)(ws + WS_P), NPI};
            pg8::gemm_phase<pg8::EpiBf16, pg8::DenseOrder>(F.lds, F.tid, g, S, E);
            );
            SEAM(base + 1);
        }
        if (IN(base + 2)) { PHASE_BEGIN(); prep_phase(p, F, l, ctx_out); if ((PROBE_DUP) == 2) { GRID_BAR(); prep_phase(p, F, l, ctx_out, 10); } if ((PROBE_DUP) == 21) { GRID_BAR(); prep_phase(p, F, l, ctx_out, 5, (WS_G - WS_P) / 2); } if ((PROBE_DUP) == 23) { GRID_BAR(); prep_phase(p, F, l, ctx_out, 2); } SEAM(base + 2); }
        if (IN(base + 3)) { RUNPH(3, PHASE_BEGIN(); mixer_phase(p, F, l, ctx_out);); SEAM(base + 3); }
        if (IN(base + 4)) { RUNPH(4, PHASE_BEGIN(); cd_combine_phase(p, F, l, ctx_out);); SEAM(base + 4); }
        if (IN(base + 5)) {
            if (l == 0 && (PROBE_DUP) == 5) {
              PHASE_BEGIN();
              { pg8::Gemm g{(const bf16*)(ws + WS_MIX), (const bf16*)(ws + WS_WOUT), D, D};
                pg8::DenseOrder S; S.init(NLAT / 256, D / 256, F.G, F.bid);
                pg8::EpiResid E{p->in[I_X], p->in[I_CTX], (float*)(ws + WS_X), (const float*)(ws + WS_MOD) + 2 * D};
                pg8::gemm_phase<pg8::EpiResid, pg8::DenseOrder>(F.lds, F.tid, g, S, E); }
              { pg8::Gemm g{(const bf16*)(ws + WS_MIX), (const bf16*)(ws + WS_WOUT), D / OUT_KS, D};
                pg8::SplitOrder S{NLAT / 256, NCTX / 256, D / 256, OUT_KS, 2 * D / OUT_KS, F.G, F.bid, nullptr};
                pg8::EpiPart E{(float*)(ws + WS_SPLIT), D, NLAT / 256, (size_t)NCTX * D};
                pg8::gemm_phase<pg8::EpiPart, pg8::SplitOrder>(F.lds, F.tid, g, S, E); }
              GRID_BAR();
            }
            PHASE_BEGIN();
            { pg8::Gemm g{(const bf16*)(ws + WS_MIX), (const bf16*)(ws + WS_WOUT) + (size_t)l * D * D, D, D};
              pg8::DenseOrder S; S.init(NLAT / 256, D / 256, F.G, F.bid);
              const float* xs = (const float*)(ws + WS_X);
              pg8::EpiResid E{l == 0 ? p->in[I_X] : xs, l == 0 ? p->in[I_CTX] : xs + (size_t)NLAT * D, (float*)(ws + WS_X), (const float*)(ws + WS_MOD) + (size_t)l * 5 * MODW + 2 * D};
              pg8::gemm_phase<pg8::EpiResid, pg8::DenseOrder>(F.lds, F.tid, g, S, E); }
            if (l == 0) {
              pg8::Gemm g{(const bf16*)(ws + WS_MIX), (const bf16*)(ws + WS_WOUT) + (size_t)l * D * D, D / OUT_KS, D};
              pg8::SplitOrder S{NLAT / 256, NCTX / 256, D / 256, OUT_KS, 2 * D / OUT_KS, F.G, F.bid, nullptr};
              pg8::EpiPart E{(float*)(ws + WS_SPLIT), D, NLAT / 256, (size_t)NCTX * D};
              pg8::gemm_phase<pg8::EpiPart, pg8::SplitOrder>(F.lds, F.tid, g, S, E); }
            SEAM(base + 5);
        }
        if (l == 0) {
            if (IN(base + 6)) { RUNPH(6, PHASE_BEGIN(); norm_phase<false, (FFU_FP8) != 0, 2>(p, F, l, false, p->in[I_NFFN] + (size_t)l * D, 3, 4, MT);); SEAM(base + 6); }
            if (IN(base + 7)) {
                RUNPH(7,
                PHASE_BEGIN();
                pg8::Gemm g{(const bf16*)(ws + WS_H), (const bf16*)(ws + WS_W13), (FFU_FP8) ? D / 2 : D, (FFU_FP8) ? D / 2 : D};
                if (F.bid < FFU_GEMM_WGS) {
                    pg8::DenseOrder S; S.init(MT / 256, 2 * FFD / 256, FFU_GEMM_WGS, F.bid);
                    pg8::EpiSwiglu8 E{(unsigned char*)(ws + WS_G), FFD};
                    pg8::gemm_phase<pg8::EpiSwiglu8, pg8::DenseOrder, true, true, (FFU_FP8) != 0>(F.lds, F.tid, g, S, E);
                }
                conv_drain(p, F, CV_L1_ITEMS + CV_FFU_ITEMS);
                );
                SEAM(base + 7);
            }
            if (IN(base + 8)) {
                PHASE_BEGIN();
                if ((PROBE_DUP) == 9) {
                  { pg8::Gemm g{(const bf16*)(ws + WS_G), (const bf16*)(ws + WS_W2), FFD / 2, FFD / 2};
                    pg8::DenseOrder S; S.init(NLAT / 256, D / 256, F.G, F.bid);
                    pg8::EpiF32 E{(float*)(ws + WS_Y), D};
                    pg8::gemm_phase<pg8::EpiF32, pg8::DenseOrder, true, true, true>(F.lds, F.tid, g, S, E); }
                  { pg8::Gemm g{(const bf16*)(ws + WS_G), (const bf16*)(ws + WS_W2), FFD / FFD_KS / 2, FFD / 2};
                    pg8::SplitOrder S{NLAT / 256, NCTX / 256, D / 256, FFD_KS, FFD / FFD_KS, F.G, F.bid, nullptr};
                    pg8::EpiPart E{(float*)(ws + WS_SPLIT), D, NLAT / 256, (size_t)NCTX * D};
                    pg8::gemm_phase<pg8::EpiPart, pg8::SplitOrder, true, true, true>(F.lds, F.tid, g, S, E); }
                  GRID_BAR();
                }
                { pg8::Gemm g{(const bf16*)(ws + WS_G), (const bf16*)(ws + WS_W2), FFD / 2, FFD / 2};
                  pg8::DenseOrder S; S.init(NLAT / 256, D / 256, F.G, F.bid);
                  const float* xs = (const float*)(ws + WS_X);
                  pg8::EpiResid E{xs, xs + (size_t)NLAT * D, (float*)(ws + WS_X), (const float*)(ws + WS_MOD) + (size_t)l * 5 * MODW + 5 * D};
                  pg8::gemm_phase<pg8::EpiResid, pg8::DenseOrder, true, true, true>(F.lds, F.tid, g, S, E); }
                { pg8::Gemm g{(const bf16*)(ws + WS_G), (const bf16*)(ws + WS_W2), FFD / FFD_KS / 2, FFD / 2};
                  pg8::SplitOrder S{NLAT / 256, NCTX / 256, D / 256, FFD_KS, FFD / FFD_KS, F.G, F.bid, nullptr};
                  pg8::EpiPart E{(float*)(ws + WS_SPLIT), D, NLAT / 256, (size_t)NCTX * D};
                  pg8::gemm_phase<pg8::EpiPart, pg8::SplitOrder, true, true, true>(F.lds, F.tid, g, S, E); }
                SEAM(base + 8);
            }
        } else {
            if (IN(base + 6)) { PHASE_BEGIN();
                if ((PROBE_DUP) == 16) { norm_phase<true, true>(p, F, l, false, p->in[I_NFFN] + (size_t)l * D, 3, 4, NLAT); GRID_BAR(); if (F.bid == 0 && F.tid < 8) ((unsigned*)(ws + WS_CTL))[CW_CNT + F.tid] = 0u; GRID_BAR(); }
                norm_phase<true, true>(p, F, l, false, p->in[I_NFFN] + (size_t)l * D, 3, 4, NLAT); SEAM(base + 6); }
            if (IN(base + 7)) { PHASE_BEGIN();
                if ((PROBE_DUP) == 17) { moe_gather_phase(p, F); GRID_BAR(); if (F.bid == 0 && F.tid < 8) ((unsigned*)(ws + WS_CTL))[CW_CUR + F.tid] = 0u; GRID_BAR(); }
                moe_gather_phase(p, F); conv_drain(p, F, CV_L1_ITEMS + CV_FFU_ITEMS);
                if ((PROBE_DUP) == 107) { GRID_BAR(); if (F.bid == 0 && F.tid == 0) __hip_atomic_store((unsigned*)(ws + WS_CTL) + CW_CONV, (unsigned)CV_L1_ITEMS, __ATOMIC_RELAXED, __HIP_MEMORY_SCOPE_AGENT); GRID_BAR(); conv_drain(p, F, CV_DEF_ITEMS); }
                SEAM(base + 7); }
            if (IN(base + 8)) {
                RUNPH(108,
                PHASE_BEGIN();
                const unsigned* ctl = (const unsigned*)(ws + WS_CTL);
                volatile LAS unsigned char* pe = (volatile LAS unsigned char*)(F.lds + MISC_OFF + 256);
                const int np = (int)ctl[CW_PANEL];
                if (F.tid < 128) pe[F.tid] = (unsigned char)(F.tid < np ? ctl[CW_PANEL + 1 + F.tid] : 0u);
                __syncthreads();
                pg8::Gemm g{(const bf16*)(ws + WS_HS), (const bf16*)(ws + WS_W13E), D / 2, D / 2};
                const int units = np * (2 * FFE / 256), rounds = (units + F.G - 1) / F.G + 1, gw = (((units + rounds - 1) / rounds) + 7) & ~7;
                if (F.bid < gw) {
                    pg8::MoeOrder S; S.init(np, 2 * FFE / 256, gw, F.bid); S.pe = pe;
                    pg8::EpiSwiglu8 E{(unsigned char*)(ws + WS_G), FFE};
                    pg8::gemm_phase<pg8::EpiSwiglu8, pg8::MoeOrder, true, true, true>(F.lds, F.tid, g, S, E);
                }
                conv_drain(p, F, CV_DEF_ITEMS);
                );
                SEAM(base + 8);
            }
            if (IN(base + 9)) {
                RUNPH(109,
                PHASE_BEGIN();
                const unsigned* ctl = (const unsigned*)(ws + WS_CTL);
                volatile LAS unsigned char* pe = (volatile LAS unsigned char*)(F.lds + MISC_OFF + 256);
                const int np = (int)ctl[CW_PANEL];
                if (F.tid < 128) pe[F.tid] = (unsigned char)(F.tid < np ? ctl[CW_PANEL + 1 + F.tid] : 0u);
                __syncthreads();
                const int nfull = np < MOE_FULL_PANELS ? np : MOE_FULL_PANELS;
                { pg8::Gemm g{(const bf16*)(ws + WS_G), (const bf16*)(ws + WS_W2E), FFE / 2, FFE / 2};
                  pg8::MoeOrder S; S.init(nfull, D / 256, F.G, F.bid); S.pe = pe;
                  pg8::EpiBf16 E{(bf16*)(ws + WS_Y), D};
                  pg8::gemm_phase<pg8::EpiBf16, pg8::MoeOrder, true, true, true>(F.lds, F.tid, g, S, E); }
                if (np > nfull) {
                  pg8::Gemm g{(const bf16*)(ws + WS_G), (const bf16*)(ws + WS_W2E), FFE / MOE_KS / 2, FFE / 2};
                  pg8::SplitOrder S{MOE_FULL_PANELS, np - nfull, D / 256, MOE_KS, FFE / MOE_KS, F.G, F.bid, pe};
                  pg8::EpiPart E{(float*)(ws + WS_SPLIT), D, MOE_FULL_PANELS, (size_t)8 * 256 * D};
                  pg8::gemm_phase<pg8::EpiPart, pg8::SplitOrder, true, true, true>(F.lds, F.tid, g, S, E); }
                );
                SEAM(base + 9);
            }
            if (IN(base + 10)) { RUNPH(22, PHASE_BEGIN(); final_phase(p, F);); }
        }
}

__global__ void __launch_bounds__(NTHR, 2) fwd_kernel(Params pv) {
    extern __shared__ __attribute__((aligned(16))) unsigned char lds_raw[];
    LAS unsigned char* const ldsb = (LAS unsigned char*)lds_raw;
    const KP kp0 = (KP)__builtin_amdgcn_kernarg_segment_ptr();
    { volatile LAS unsigned* MISC = (volatile LAS unsigned*)(ldsb + MISC_OFF);
      for (int u = threadIdx.x; u < 256; u += NTHR) MISC[u] = 0u; }
    __syncthreads();
    const int lo = kp0->ph_lo, hi = kp0->ph_hi;
    if ((hi - lo) > 1) (void)xcd_barrier_post((unsigned*)(kp0->ws + WS_CTL) + CW_BAR, (volatile LAS unsigned*)(ldsb + MISC_OFF) + 8);
    if (IN(0)) { RUNPH(0, PHASE_BEGIN(); p0_prologue(p, F);); SEAM(0); }
    layer_phases<0>(kp0, ldsb, lo, hi);
    layer_phases<1>(kp0, ldsb, lo, hi);
}
#undef IN
#undef SEAM
#undef GRID_BAR
#undef RUNPH
#undef PHASE_BEGIN

extern "C" void kernel_launch(void* const* d_in, const int* in_sizes, int n_in, void* d_out, int out_size, void* d_ws, size_t ws_size, hipStream_t stream) {
    static int grid = 0;
    if (grid == 0) {
        if (n_in != 26 || out_size != NLAT * D || ws_size < WS_END) { fprintf(stderr, "kernel_launch: unexpected shapes (n_in %d out %d ws %zu need %zu)\n", n_in, out_size, ws_size, (size_t)WS_END); grid = -1; return; }
        int dev = 0, cus = 0, per_cu = 0;
        if (hipGetDevice(&dev) != hipSuccess || hipDeviceGetAttribute(&cus, hipDeviceAttributeMultiprocessorCount, dev) != hipSuccess) { grid = -1; return; }
        if (hipFuncSetAttribute((const void*)fwd_kernel, hipFuncAttributeMaxDynamicSharedMemorySize, LDS_BYTES) != hipSuccess) { fprintf(stderr, "kernel_launch: hipFuncSetAttribute failed\n"); grid = -1; return; }
        if (hipOccupancyMaxActiveBlocksPerMultiprocessor(&per_cu, (const void*)fwd_kernel, NTHR, LDS_BYTES) != hipSuccess || per_cu < 1) fprintf(stderr, "kernel_launch: occupancy query says %d\n", per_cu);
        (void)hipGetLastError();
        grid = cus;
    }
    if (grid < 0) return;
    (void)hipMemsetAsync((char*)d_ws + WS_CTL, 0, CTL_BYTES, stream);
    Params p{};
    for (int i = 0; i < 26; ++i) p.in[i] = (const float*)d_in[i];
    p.out = (float*)d_out; p.ws = (unsigned char*)d_ws;
#if MK_ONE_LAUNCH
    p.ph_lo = 0; p.ph_hi = PH_END;
    hipLaunchKernelGGL(fwd_kernel, dim3(grid), dim3(NTHR), LDS_BYTES, stream, p);
#else
    const int phases[] = {0, 1, 2, 3, 4, 5, 6, 7, 8, 9, 12, 13, 14, 15, 16, 17, 18, 19, 20, 21, 22};
    for (int i = 0; i < (int)(sizeof(phases) / sizeof(phases[0])); ++i) { p.ph_lo = phases[i]; p.ph_hi = phases[i] + 1; hipLaunchKernelGGL(fwd_kernel, dim3(grid), dim3(NTHR), LDS_BYTES, stream, p); }
#endif
}
```
